# Optimizing an MI355X kernel written in HIP

```python
import math
import jax, jax.numpy as jnp
from jax import lax
import numpy as np

D_MODEL = 1024
BATCH = 4
SEQ = 4096
DEPTH = 1
DEC_BATCH = 128
DEC_SEQ = 8
PAST_LEN = 8192
PAGE_SIZE = 128

SSM_WIDTH = D_MODEL // 2
SSM_GROUP = 16
SSM_GROUPS = SSM_WIDTH // SSM_GROUP
SSM_STATE = 64
N_HEADS = 8
N_KV_HEADS = 2
Q_PER_KV = N_HEADS // N_KV_HEADS
HEAD_DIM = 64
ATTN_WIDTH = N_HEADS * HEAD_DIM
KV_WIDTH = N_KV_HEADS * HEAD_DIM
WINDOW = 128
ROPE_DIM = HEAD_DIM // 4
ROPE_THETA = 500000.0
SPLITS = [SSM_WIDTH, SSM_WIDTH + ATTN_WIDTH, SSM_WIDTH + ATTN_WIDTH + KV_WIDTH,
          SSM_WIDTH + ATTN_WIDTH + 2 * KV_WIDTH, SSM_WIDTH + ATTN_WIDTH + 2 * KV_WIDTH + D_MODEL]
IN_WIDTH = SSM_WIDTH + ATTN_WIDTH + 2 * KV_WIDTH + 2 * D_MODEL
PEER_HEADS = 8
PEER_KEYS = 128
PEER_EXPERTS = PEER_KEYS * PEER_KEYS
PEER_KEY_DIM = 128
PEER_HALF = PEER_KEY_DIM // 2
PEER_TOPK = 16
PEER_BLOCK = 128
ALPHA = (2.0 * DEPTH) ** 0.25
BETA = (8.0 * DEPTH) ** -0.25
LN_EPS = 1e-5
NEG_INF = -1e30

kernel_name = "hybrid_s5_swa_peer_deepnorm_step"


def layer_norm(x, g, b):
    xf = x.astype(jnp.float32)
    mu = jnp.mean(xf, axis=-1, keepdims=True)
    var = jnp.mean(jnp.square(xf - mu), axis=-1, keepdims=True)
    return ((xf - mu) * lax.rsqrt(var + LN_EPS) * g.astype(jnp.float32) + b.astype(jnp.float32)).astype(x.dtype)


def partial_rope(x, pos):
    freqs = ROPE_THETA ** (-jnp.arange(0, ROPE_DIM, 2, dtype=jnp.float32) / ROPE_DIM)
    ang = pos.astype(jnp.float32)[:, None] * freqs[None, :]
    cos = jnp.cos(ang)[:, None, :]
    sin = jnp.sin(ang)[:, None, :]
    xr = x[..., :ROPE_DIM].astype(jnp.float32)
    x1, x2 = xr[..., :ROPE_DIM // 2], xr[..., ROPE_DIM // 2:]
    rot = jnp.concatenate([x1 * cos - x2 * sin, x2 * cos + x1 * sin], axis=-1)
    return jnp.concatenate([rot.astype(x.dtype), x[..., ROPE_DIM:]], axis=-1)


def s5_scan(u, h0_re, h0_im, a_re, a_im, log_dt, b_re, b_im, c_re, c_im, d):
    f32 = jnp.float32
    bsz, t = u.shape[0], u.shape[1]
    dt = jnp.exp(log_dt.astype(f32))[:, None]
    a = lax.complex(a_re.astype(f32), a_im.astype(f32))
    a_bar = jnp.exp(a * dt)
    b = lax.complex(b_re.astype(f32), b_im.astype(f32))
    b_bar = ((a_bar - 1.0) / a)[..., None] * b
    ug = u.astype(f32).reshape(bsz, t, SSM_GROUPS, SSM_GROUP).astype(jnp.complex64)
    bu = jnp.einsum('gpc,btgc->btgp', b_bar, ug)
    h0 = lax.complex(h0_re.astype(f32), h0_im.astype(f32))
    bu = bu.at[:, 0].add(a_bar[None] * h0)
    decay = jnp.broadcast_to(a_bar, bu.shape)

    def combine(l, r):
        return (r[0] * l[0], r[0] * l[1] + r[1])

    _, hs = lax.associative_scan(combine, (decay, bu), axis=1)
    c = lax.complex(c_re.astype(f32), c_im.astype(f32))
    y = jnp.real(jnp.einsum('gcp,btgp->btgc', c, hs)).reshape(bsz, t, SSM_WIDTH)
    y = y + d.astype(f32) * u.astype(f32)
    h_last = hs[:, -1]
    return y.astype(u.dtype), jnp.real(h_last), jnp.imag(h_last)


def sink_attention(q, k, v, mask, sinks):
    f32 = jnp.float32
    s = jnp.einsum('bnqkgd,bnskd->bnkgqs', q.astype(f32), k.astype(f32)) * (HEAD_DIM ** -0.5)
    s = jnp.where(mask[None, :, None, None], s, NEG_INF)
    sink = jnp.broadcast_to(sinks.astype(f32).reshape(N_KV_HEADS, Q_PER_KV)[None, None, :, :, None, None],
                            s.shape[:-1] + (1,))
    p = jax.nn.softmax(jnp.concatenate([s, sink], axis=-1), axis=-1)[..., :-1]
    o = jnp.einsum('bnkgqs,bnskd->bnqkgd', p, v.astype(f32))
    return o.astype(q.dtype)


def window_attention_prompt(q, k, v, sinks):
    bsz, t = q.shape[0], q.shape[1]
    nb = t // WINDOW
    qb = q.reshape(bsz, nb, WINDOW, N_KV_HEADS, Q_PER_KV, HEAD_DIM)
    pad = ((0, 0), (WINDOW, 0), (0, 0), (0, 0))
    kp = jnp.pad(k, pad).reshape(bsz, nb + 1, WINDOW, N_KV_HEADS, HEAD_DIM)
    vp = jnp.pad(v, pad).reshape(bsz, nb + 1, WINDOW, N_KV_HEADS, HEAD_DIM)
    kb = jnp.concatenate([kp[:, :-1], kp[:, 1:]], axis=2)
    vb = jnp.concatenate([vp[:, :-1], vp[:, 1:]], axis=2)
    qi = jnp.arange(WINDOW)[:, None]
    sj = jnp.arange(2 * WINDOW)[None, :]
    rel = WINDOW + qi - sj
    band = (rel >= 0) & (rel < WINDOW)
    valid = (jnp.arange(nb)[:, None, None] > 0) | (sj[None] >= WINDOW)
    mask = band[None] & valid
    o = sink_attention(qb, kb, vb, mask, sinks)
    return o.reshape(bsz, t, ATTN_WIDTH), k[:, t - WINDOW:], v[:, t - WINDOW:]


def window_attention_sample(q, k_new, v_new, k_buf, v_buf, sinks):
    bsz, s = q.shape[0], q.shape[1]
    kk = jnp.concatenate([k_buf.astype(k_new.dtype), k_new], axis=1)
    vv = jnp.concatenate([v_buf.astype(v_new.dtype), v_new], axis=1)
    rel = (jnp.arange(s)[:, None] + WINDOW) - jnp.arange(WINDOW + s)[None, :]
    mask = (rel >= 0) & (rel < WINDOW)
    qb = q.reshape(bsz, 1, s, N_KV_HEADS, Q_PER_KV, HEAD_DIM)
    o = sink_attention(qb, kk[:, None], vv[:, None], mask[None], sinks)
    return o.reshape(bsz, s, ATTN_WIDTH), kk[:, s:], vv[:, s:]


def token_mixer(x, pos, h0_re, h0_im, k_buf, v_buf, p):
    bsz, t = x.shape[0], x.shape[1]
    z = x @ p['w_in'] + p['b_in']
    u, q, k, v, g_ssm, g_attn = jnp.split(z, SPLITS, axis=-1)
    y, h_re, h_im = s5_scan(u, h0_re, h0_im, p['ssm_a_re'], p['ssm_a_im'], p['ssm_log_dt'],
                            p['ssm_b_re'], p['ssm_b_im'], p['ssm_c_re'], p['ssm_c_im'], p['ssm_d'])
    hg = jax.nn.gelu(y, approximate=False)
    ga, gb = jnp.split(hg @ p['w_glu'] + p['b_glu'], 2, axis=-1)
    ssm_branch = ga * jax.nn.sigmoid(gb)
    q = partial_rope(q.reshape(bsz, t, N_HEADS, HEAD_DIM), pos)
    k = partial_rope(k.reshape(bsz, t, N_KV_HEADS, HEAD_DIM), pos)
    v = v.reshape(bsz, t, N_KV_HEADS, HEAD_DIM)
    if k_buf is None:
        o, k_win, v_win = window_attention_prompt(q, k, v, p['attn_sinks'])
    else:
        o, k_win, v_win = window_attention_sample(q, k, v, k_buf, v_buf, p['attn_sinks'])
    attn_branch = o @ p['w_attn_up']
    merged = jax.nn.sigmoid(g_ssm) * ssm_branch + jax.nn.sigmoid(g_attn) * attn_branch
    return merged @ p['w_out'], k_win, v_win, h_re, h_im


def peer(x, p):
    f32 = jnp.float32
    bsz, t, dm = x.shape
    xf = x.reshape(-1, dm)
    n = xf.shape[0]
    q = (xf @ p['peer_wq']).astype(f32).reshape(n, PEER_HEADS, 2, PEER_HALF)
    s1 = jnp.einsum('nhd,hkd->nhk', q[:, :, 0], p['peer_k1'].astype(f32))
    s2 = jnp.einsum('nhd,hkd->nhk', q[:, :, 1], p['peer_k2'].astype(f32))
    v1, i1 = lax.top_k(s1, PEER_TOPK)
    v2, i2 = lax.top_k(s2, PEER_TOPK)
    cand = (v1[..., :, None] + v2[..., None, :]).reshape(n, PEER_HEADS, PEER_TOPK * PEER_TOPK)
    cidx = (i1[..., :, None] * PEER_KEYS + i2[..., None, :]).reshape(n, PEER_HEADS, PEER_TOPK * PEER_TOPK)
    sc, sel = lax.top_k(cand, PEER_TOPK)
    idx = jnp.take_along_axis(cidx, sel, axis=-1)
    gate = jax.nn.softmax(sc, axis=-1)
    n_pad = (-n) % PEER_BLOCK
    nblk = (n + n_pad) // PEER_BLOCK
    xb = jnp.pad(xf, ((0, n_pad), (0, 0))).reshape(nblk, PEER_BLOCK, dm)
    ib = jnp.pad(idx, ((0, n_pad), (0, 0), (0, 0))).reshape(nblk, PEER_BLOCK, PEER_HEADS, PEER_TOPK)
    gbk = jnp.pad(gate, ((0, n_pad), (0, 0), (0, 0))).reshape(nblk, PEER_BLOCK, PEER_HEADS, PEER_TOPK)
    peer_u, peer_v = p['peer_u'], p['peer_v']

    def expert_block(args):
        xi, ii, gi = args
        h = jnp.einsum('nhkd,nd->nhk', peer_u[ii], xi)
        a = jax.nn.gelu(h.astype(f32), approximate=False) * gi
        return jnp.einsum('nhk,nhkd->nd', a.astype(x.dtype), peer_v[ii])

    out = lax.map(expert_block, (xb, ib, gbk)).reshape(-1, dm)[:n]
    return out.reshape(bsz, t, dm).astype(x.dtype)


def decoder_layer(x, pos, h0_re, h0_im, k_buf, v_buf, p):
    mix, k_win, v_win, h_re, h_im = token_mixer(x, pos, h0_re, h0_im, k_buf, v_buf, p)
    x1 = layer_norm(ALPHA * x + mix, p['ln1_g'], p['ln1_b'])
    x2 = layer_norm(ALPHA * x1 + peer(x1, p), p['ln2_g'], p['ln2_b'])
    return x2, k_win, v_win, h_re, h_im


def setup_inputs(seed: int = 0) -> dict:
    key = jax.random.key(seed)
    ks = jax.random.split(key, 32)
    nrm = lambda k, shape, s: jax.random.normal(k, shape, jnp.float32) * s
    L = DEPTH
    a_im_base = math.pi * jnp.arange(SSM_STATE, dtype=jnp.float32)
    return {
        'x_prompt': nrm(ks[0], (BATCH, SEQ, D_MODEL), 1.0),
        'x_sample': nrm(ks[1], (DEC_BATCH, DEC_SEQ, D_MODEL), 1.0),
        'cache_k_win': nrm(ks[2], (L, DEC_BATCH, WINDOW, N_KV_HEADS, HEAD_DIM), 1.0),
        'cache_v_win': nrm(ks[3], (L, DEC_BATCH, WINDOW, N_KV_HEADS, HEAD_DIM), 1.0),
        'state_ssm_re': nrm(ks[4], (L, DEC_BATCH, SSM_GROUPS, SSM_STATE), 0.1),
        'state_ssm_im': nrm(ks[5], (L, DEC_BATCH, SSM_GROUPS, SSM_STATE), 0.1),
        'w_in': nrm(ks[6], (L, D_MODEL, IN_WIDTH), D_MODEL ** -0.5),
        'b_in': nrm(ks[7], (L, IN_WIDTH), 0.01),
        'ssm_a_re': -0.5 + nrm(ks[8], (L, SSM_GROUPS, SSM_STATE), 0.01),
        'ssm_a_im': a_im_base + nrm(ks[9], (L, SSM_GROUPS, SSM_STATE), 0.01),
        'ssm_log_dt': jax.random.uniform(ks[10], (L, SSM_GROUPS), jnp.float32, math.log(1e-3), math.log(1e-1)),
        'ssm_b_re': nrm(ks[11], (L, SSM_GROUPS, SSM_STATE, SSM_GROUP), (2.0 * SSM_GROUP) ** -0.5),
        'ssm_b_im': nrm(ks[12], (L, SSM_GROUPS, SSM_STATE, SSM_GROUP), (2.0 * SSM_GROUP) ** -0.5),
        'ssm_c_re': nrm(ks[13], (L, SSM_GROUPS, SSM_GROUP, SSM_STATE), SSM_STATE ** -0.5),
        'ssm_c_im': nrm(ks[14], (L, SSM_GROUPS, SSM_GROUP, SSM_STATE), SSM_STATE ** -0.5),
        'ssm_d': nrm(ks[15], (L, SSM_WIDTH), 1.0),
        'w_glu': nrm(ks[16], (L, SSM_WIDTH, 2 * D_MODEL), SSM_WIDTH ** -0.5),
        'b_glu': nrm(ks[17], (L, 2 * D_MODEL), 0.01),
        'attn_sinks': nrm(ks[18], (L, N_HEADS), 0.5),
        'w_attn_up': nrm(ks[19], (L, ATTN_WIDTH, D_MODEL), ATTN_WIDTH ** -0.5),
        'w_out': nrm(ks[20], (L, D_MODEL, D_MODEL), BETA * D_MODEL ** -0.5),
        'ln1_g': 1.0 + nrm(ks[21], (L, D_MODEL), 0.01),
        'ln1_b': nrm(ks[22], (L, D_MODEL), 0.01),
        'peer_wq': nrm(ks[23], (L, D_MODEL, PEER_HEADS * PEER_KEY_DIM), D_MODEL ** -0.5),
        'peer_k1': nrm(ks[24], (L, PEER_HEADS, PEER_KEYS, PEER_HALF), PEER_HALF ** -0.5),
        'peer_k2': nrm(ks[25], (L, PEER_HEADS, PEER_KEYS, PEER_HALF), PEER_HALF ** -0.5),
        'peer_u': nrm(ks[26], (L, PEER_EXPERTS, D_MODEL), D_MODEL ** -0.5),
        'peer_v': nrm(ks[27], (L, PEER_EXPERTS, D_MODEL), BETA * D_MODEL ** -0.5),
        'ln2_g': 1.0 + nrm(ks[28], (L, D_MODEL), 0.01),
        'ln2_b': nrm(ks[29], (L, D_MODEL), 0.01),
    }


def reference(x_prompt, x_sample, cache_k_win, cache_v_win, state_ssm_re, state_ssm_im,
              w_in, b_in, ssm_a_re, ssm_a_im, ssm_log_dt, ssm_b_re, ssm_b_im, ssm_c_re, ssm_c_im,
              ssm_d, w_glu, b_glu, attn_sinks, w_attn_up, w_out, ln1_g, ln1_b,
              peer_wq, peer_k1, peer_k2, peer_u, peer_v, ln2_g, ln2_b):
    pos_prompt = jnp.arange(SEQ, dtype=jnp.int32)
    pos_sample = PAST_LEN + jnp.arange(DEC_SEQ, dtype=jnp.int32)
    zero_state = jnp.zeros((BATCH, SSM_GROUPS, SSM_STATE), jnp.float32)
    xp, xs = x_prompt, x_sample
    kwp, vwp, hrp, hip, kws, vws, hrs, his = [], [], [], [], [], [], [], []
    for l in range(DEPTH):
        p = {
            'w_in': w_in[l], 'b_in': b_in[l], 'ssm_a_re': ssm_a_re[l], 'ssm_a_im': ssm_a_im[l],
            'ssm_log_dt': ssm_log_dt[l], 'ssm_b_re': ssm_b_re[l], 'ssm_b_im': ssm_b_im[l],
            'ssm_c_re': ssm_c_re[l], 'ssm_c_im': ssm_c_im[l], 'ssm_d': ssm_d[l],
            'w_glu': w_glu[l], 'b_glu': b_glu[l], 'attn_sinks': attn_sinks[l],
            'w_attn_up': w_attn_up[l], 'w_out': w_out[l], 'ln1_g': ln1_g[l], 'ln1_b': ln1_b[l],
            'peer_wq': peer_wq[l], 'peer_k1': peer_k1[l], 'peer_k2': peer_k2[l],
            'peer_u': peer_u[l], 'peer_v': peer_v[l], 'ln2_g': ln2_g[l], 'ln2_b': ln2_b[l],
        }
        xp, kw, vw, hr, hi = decoder_layer(xp, pos_prompt, zero_state, zero_state, None, None, p)
        kwp.append(kw); vwp.append(vw); hrp.append(hr); hip.append(hi)
        xs, kw, vw, hr, hi = decoder_layer(xs, pos_sample, state_ssm_re[l], state_ssm_im[l],
                                           cache_k_win[l], cache_v_win[l], p)
        kws.append(kw); vws.append(vw); hrs.append(hr); his.append(hi)
    return (xp, xs, jnp.stack(kwp), jnp.stack(vwp), jnp.stack(hrp), jnp.stack(hip),
            jnp.stack(kws), jnp.stack(vws), jnp.stack(hrs), jnp.stack(his))
```

```cpp
#include <hip/hip_runtime.h>
#include <hip/hip_bf16.h>
#include <hip/hip_cooperative_groups.h>
#include <cstdio>
namespace cg = cooperative_groups;

#ifndef MEGA
#define MEGA 1
#endif
#define REP -1

typedef unsigned short u16;
using bf16x8 = __attribute__((ext_vector_type(8))) short;
using bf16x4 = __attribute__((ext_vector_type(4))) short;
using f32x4 = __attribute__((ext_vector_type(4))) float;
using f32x16 = __attribute__((ext_vector_type(16))) float;
using f32x2 = __attribute__((ext_vector_type(2))) float;

constexpr int NP = 16384, NS = 1024, NT = 17408;
constexpr float ALPHA = 1.189207115002721f;
constexpr int NPHASE = 10;
constexpr int LDS_BYTES = 131072;
constexpr float PU_SCALE = 256.f, PV_SCALE = 512.f;

constexpr size_t R0 = 0, R1 = 71303168, R2 = 142606336, R3 = 213909504, R4 = 249561088;
constexpr size_t OFF_XB = R0, OFF_WIN = R0 + 35651584, OFF_EB = R0 + 42467328, OFF_TB = R0 + 44564480,
                 OFF_TBS = R0 + 50855936, OFF_HIN = R0 + 52953088, OFF_MS = R0, OFF_RX = R0;
constexpr size_t OFF_GS = R1, OFF_GA = R1 + 35651584, OFF_MERGED = R1, OFF_PU = R1 + 35651584, OFF_PV = R1 + 35651584 + 16777216;
constexpr size_t OFF_ZU = R2, OFF_ZQ = R2 + 17825792, OFF_ZK = R2 + 35651584, OFF_ZV = R2 + 40108032,
                 OFF_SLOC = R2 + 44564480, OFF_SC = R2;
constexpr size_t OFF_AO = R3, OFF_HG = R3 + 17825792, OFF_X1B = R3;
constexpr size_t OFF_WGLU = R4, OFF_WUP = R4 + 2097152, OFF_WOUT = R4 + 3145728, OFF_WPQ = R4 + 5242880,
                 OFF_ROPE = R4 + 9437184, OFF_LAM = R4 + 9699840, WS_END = R4 + 9732608;

constexpr long O_Y = 0, O_KWP = 17825792, O_VWP = O_KWP + 65536, O_HRP = O_VWP + 65536, O_HIP = O_HRP + 8192,
               O_KWS = O_HIP + 8192, O_VWS = O_KWS + 2097152, O_HRS = O_VWS + 2097152, O_HIS = O_HRS + 262144;

#if defined(__HIP_DEVICE_COMPILE__)
#define GPTR __attribute__((address_space(1)))
#else
#define GPTR
#endif
struct Params {
  const GPTR float *x_prompt, *x_sample, *cache_k, *cache_v, *st_re, *st_im, *w_in, *b_in, *a_re, *a_im, *log_dt, *b_re, *b_im,
      *c_re, *c_im, *ssm_d, *w_glu, *b_glu, *sinks, *w_up, *w_out, *ln1_g, *ln1_b, *peer_wq, *peer_k1, *peer_k2, *peer_u,
      *peer_v, *ln2_g, *ln2_b;
  GPTR float* out;
  GPTR unsigned char* ws;
};

typedef __bf16 hwbf16x2 __attribute__((ext_vector_type(2)));
__device__ __forceinline__ unsigned pack2(float a, float b) {
  const f32x2 f = {a, b};
  const hwbf16x2 v = __builtin_convertvector(f, hwbf16x2);
  return __builtin_bit_cast(unsigned, v);
}
__device__ __forceinline__ u16 f2bf(float f) { return (u16)(pack2(f, 0.f) & 0xffffu); }
__device__ __forceinline__ float bf2f(u16 h) { return __uint_as_float(((unsigned)h) << 16); }
__device__ __forceinline__ float sigm(float x) { return __builtin_amdgcn_rcpf(1.f + __expf(-x)); }
__device__ __forceinline__ float gelu_(float x) {
  const float ax = fabsf(x) * 0.70710678118654752f;
  const float t = __builtin_amdgcn_rcpf(1.f + 0.3275911f * ax);
  const float poly = t * (0.254829592f + t * (-0.284496736f + t * (1.421413741f + t * (-1.453152027f + t * 1.061405429f))));
  const float er = copysignf(1.f - poly * __expf(-ax * ax), x);
  return 0.5f * x * (1.f + er);
}
__device__ __forceinline__ float wave_max(float v) {
  for (int o = 32; o >= 1; o >>= 1) v = fmaxf(v, __shfl_xor(v, o));
  return v;
}
__device__ __forceinline__ float wave_sum(float v) {
  for (int o = 32; o >= 1; o >>= 1) v += __shfl_xor(v, o);
  return v;
}


template <int CTRL>
__device__ __forceinline__ float dpp_f(float v) {
  return __int_as_float(__builtin_amdgcn_update_dpp(0, __float_as_int(v), CTRL, 0xf, 0xf, false));
}
__device__ __forceinline__ float row_sum16(float v) {
  v += dpp_f<0x128>(v); v += dpp_f<0x124>(v); v += dpp_f<0x122>(v); v += dpp_f<0x121>(v);
  return v;
}
__device__ __forceinline__ float row_max16(float v) {
  v = fmaxf(v, dpp_f<0x128>(v)); v = fmaxf(v, dpp_f<0x124>(v)); v = fmaxf(v, dpp_f<0x122>(v)); v = fmaxf(v, dpp_f<0x121>(v));
  return v;
}
__device__ __forceinline__ float rlane(float v, int l) { return __int_as_float(__builtin_amdgcn_readlane(__float_as_int(v), l)); }
__device__ __forceinline__ float wsum(float v) {
  v = row_sum16(v);
  return (rlane(v, 0) + rlane(v, 16)) + (rlane(v, 32) + rlane(v, 48));
}
__device__ __forceinline__ int mbcnt64(unsigned long long m) {
  return __builtin_amdgcn_mbcnt_hi((unsigned)(m >> 32), __builtin_amdgcn_mbcnt_lo((unsigned)m, 0));
}
#define XB_TMO      128
#define XB_XCNT(j)  (256  + 64 * (j))
#define XB_XSUB(j)  (1280 + 64 * (j))
#define XB_XGEN(j)  (2304 + 64 * (j))
#define XB_TOP      3328
#define XB_TOPGEN   3392
#define XCD_BAR_WORDS 3456
#define XB_SPIN_CAP (1u << 18)
#define LAS __attribute__((address_space(3)))
__device__ __forceinline__ unsigned xb_ld(unsigned* p) { return __hip_atomic_load(p, __ATOMIC_RELAXED, __HIP_MEMORY_SCOPE_AGENT); }
__device__ __forceinline__ unsigned xb_add(unsigned* p, unsigned v) { return __hip_atomic_fetch_add(p, v, __ATOMIC_RELAXED, __HIP_MEMORY_SCOPE_AGENT); }
__device__ __forceinline__ unsigned xb_xcc_id() { return (unsigned)__builtin_amdgcn_s_getreg((3 << 11) | 20) & 0xFu; }
#define XB_SPIN(cond, bar) do { unsigned _sp = 0; while (cond) { __builtin_amdgcn_s_sleep(1); \
    if ((++_sp & 255u) == 0u) { if (xb_ld(&(bar)[XB_TMO])) break; if (_sp > XB_SPIN_CAP) { atomicAdd(&(bar)[XB_TMO], 1u); break; } } } } while (0)
__device__ __forceinline__ void xcd_barrier_complete(unsigned* bar, unsigned x, unsigned& nloc, unsigned& nx) {
  const unsigned G = gridDim.x;
  unsigned sum, cnt, mine, sp = 0u;
  for (;;) {
    sum = 0u; cnt = 0u; mine = 0u;
#pragma unroll
    for (unsigned j = 0; j < 16; ++j) { const unsigned c = xb_ld(&bar[XB_XCNT(j)]); sum += c; cnt += (c > 0u) ? 1u : 0u; mine = (j == x) ? c : mine; }
    if (sum == G) break;
    __builtin_amdgcn_s_sleep(1);
    if ((++sp & 255u) == 0u) { if (xb_ld(&bar[XB_TMO])) break; if (sp > XB_SPIN_CAP) { atomicAdd(&bar[XB_TMO], 1u); break; } }
  }
  nloc = mine > 0u ? mine : 1u; nx = cnt > 0u ? cnt : 1u;
}
__device__ __forceinline__ void gbar(const int tix, unsigned* bar, volatile LAS unsigned* st) {
  asm volatile("s_waitcnt vmcnt(0)" ::: "memory");
  __syncthreads();
  if (tix == 0) {
    __builtin_amdgcn_s_waitcnt(0);
    const unsigned x = xb_xcc_id();
    unsigned nloc = st[0], nx = st[1];
    if (nloc == 0u) { xcd_barrier_complete(bar, x, nloc, nx); st[0] = nloc; st[1] = nx; }
    const unsigned old = xb_add(&bar[XB_XSUB(x)], 1u);
    const unsigned gen = old / nloc;
    if (old + 1u == (gen + 1u) * nloc) {
      __builtin_amdgcn_fence(__ATOMIC_RELEASE, "agent");
      asm volatile("s_waitcnt vmcnt(0)" ::: "memory");
      const unsigned og = xb_add(&bar[XB_TOP], 1u);
      const unsigned tg = og / nx;
      if (og + 1u == (tg + 1u) * nx) xb_add(&bar[XB_TOPGEN], 1u);
      else XB_SPIN(xb_ld(&bar[XB_TOPGEN]) == tg, bar);
      __builtin_amdgcn_fence(__ATOMIC_ACQUIRE, "agent");
      xb_add(&bar[XB_XGEN(x)], 1u);
      asm volatile("s_waitcnt vmcnt(0)" ::: "memory");
    } else {
      XB_SPIN(xb_ld(&bar[XB_XGEN(x)]) == gen, bar);
      __builtin_amdgcn_fence(__ATOMIC_ACQUIRE, "agent");
      asm volatile("s_waitcnt vmcnt(0)" ::: "memory");
    }
  }
  __syncthreads();
}

__device__ __forceinline__ bf16x8 cvt8(const float* src) {
  float4 a = *(const float4*)src, b = *(const float4*)(src + 4);
  union { bf16x8 v; unsigned u[4]; } c;
  c.u[0] = pack2(a.x, a.y); c.u[1] = pack2(a.z, a.w); c.u[2] = pack2(b.x, b.y); c.u[3] = pack2(b.z, b.w);
  return c.v;
}

__device__ __forceinline__ void phase_prep(const int tix, const Params& p, unsigned char* smem, const int part, const int wk, const int nwk) {
  const long T = (long)nwk * 512;
  const long tid = (long)wk * 512 + tix;
  const int wid = tix >> 6, lane = tix & 63;
  unsigned char* ws = p.ws;
  if (part == 0) {
    u16* xb = (u16*)(ws + OFF_XB);
    for (long i = tid; i < (long)NT * 256; i += T) {
      long e = i * 4;
      const float* src = e < (long)NP * 1024 ? p.x_prompt + e : p.x_sample + (e - (long)NP * 1024);
      float4 v = *(const float4*)src;
      uint2 o;
      o.x = pack2(v.x, v.y);
      o.y = pack2(v.z, v.w);
      *(uint2*)(xb + e) = o;
    }
  }
  if (part == 1) {
    for (long i = tid; i < 128L * 3840; i += T) {
      long b = i / 3840, r = (i % 3840) * 4;
      *(float4*)(p.out + O_KWS + b * 16384 + r) = *(const float4*)(p.cache_k + b * 16384 + 1024 + r);
      *(float4*)(p.out + O_VWS + b * 16384 + r) = *(const float4*)(p.cache_v + b * 16384 + 1024 + r);
    }
  }
  if (part == 0) {
    float* rt = (float*)(ws + OFF_ROPE);
    const int per_wk = (4104 * 8 + nwk - 1) / nwk;
    for (long i = (tix < per_wk) ? (long)wk + (long)tix * nwk : 4104L * 8; i < 4104L * 8; i += 4104L * 8) {
      int pi = (int)(i / 8), f = (int)(i % 8);
      double pos = pi < 4096 ? (double)pi : (double)(8192 + pi - 4096);
      double fr = exp(-log(500000.0) * (double)f / 8.0);
      double s, c;
      sincos(pos * fr, &s, &c);
      rt[i * 2] = (float)c;
      rt[i * 2 + 1] = (float)s;
    }
  }
  {
    float* tile = (float*)smem;
    for (int t = (part == 0 ? wk : 832 + wk); t < (part == 0 ? 832 : 1472); t += nwk) {
      const float* src; u16* dst; int K, N, tt, mode = 0;
      if (t < 832) { src = p.w_in; dst = (u16*)(ws + OFF_WIN); K = 1024; N = 3328; tt = t; }
      else if (t < 1088) { src = p.w_glu; dst = (u16*)(ws + OFF_WGLU); K = 512; N = 2048; tt = t - 832; mode = 1; }
      else if (t < 1216) { src = p.w_up; dst = (u16*)(ws + OFF_WUP); K = 512; N = 1024; tt = t - 1088; }
      else { src = p.w_out; dst = (u16*)(ws + OFF_WOUT); K = 1024; N = 1024; tt = t - 1216; }
      const int ntn = N / 64, kt = tt / ntn, nt_ = tt % ntn;
      __syncthreads();
#pragma unroll
      for (int i = 0; i < 2; ++i) {
        int idx = tix + 512 * i, r = idx >> 4, c4 = idx & 15;
        float4 v = *(const float4*)(src + (long)(kt * 64 + r) * N + nt_ * 64 + c4 * 4);
        tile[r * 65 + c4 * 4] = v.x; tile[r * 65 + c4 * 4 + 1] = v.y; tile[r * 65 + c4 * 4 + 2] = v.z; tile[r * 65 + c4 * 4 + 3] = v.w;
      }
      __syncthreads();
      {
        int n = tix & 63, ks = tix >> 6;
        float f[8];
#pragma unroll
        for (int j = 0; j < 8; ++j) f[j] = tile[(ks * 8 + j) * 65 + n];
        int c = nt_ * 64 + n;
        int row = c;
        if (mode == 1) row = (c < 1024) ? ((c >> 7) * 256 + (c & 127)) : (((c - 1024) >> 7) * 256 + 128 + (c & 127));
        uint4 o;
        o.x = pack2(f[0], f[1]); o.y = pack2(f[2], f[3]); o.z = pack2(f[4], f[5]); o.w = pack2(f[6], f[7]);
        *(uint4*)(dst + (long)row * K + kt * 64 + ks * 8) = o;
      }
    }
    __syncthreads();
  }
  if (part == 1) {
    u16* w = (u16*)(ws + OFF_WPQ);
    const int r = lane & 15, fq = lane >> 4;
    for (int task = wk * 8 + wid; task < 2048; task += nwk * 8) {
      const int ntile = task >> 4, ms = task & 15, n0 = ntile * 16;
      const int h = n0 >> 8, half = (n0 >> 7) & 1, key0 = n0 & 127;
      const float* kp = (half ? p.peer_k2 : p.peer_k1) + (long)(h * 128 + key0 + r) * 64 + fq * 8;
      bf16x8 a0 = cvt8(kp), a1 = cvt8(kp + 32);
#pragma unroll
      for (int mt = 0; mt < 4; ++mt) {
        const int m = ms * 64 + mt * 16 + r;
        const float* wq = p.peer_wq + (long)m * 1024 + h * 128 + half * 64 + fq * 8;
        bf16x8 b0 = cvt8(wq), b1 = cvt8(wq + 32);
        f32x4 acc = {0.f, 0.f, 0.f, 0.f};
        acc = __builtin_amdgcn_mfma_f32_16x16x32_bf16(a0, b0, acc, 0, 0, 0);
        acc = __builtin_amdgcn_mfma_f32_16x16x32_bf16(a1, b1, acc, 0, 0, 0);
#pragma unroll
        for (int j = 0; j < 4; ++j) w[(long)(n0 + fq * 4 + j) * 1024 + m] = f2bf(acc[j]);
      }
    }
  }
  if (part == 1) {
    float* lamr = (float*)smem;
    float* lami = lamr + 64 * 17;
    float* qre = lami + 64 * 17;
    float* qim = qre + 64;
    u16* EB = (u16*)(ws + OFF_EB);
    u16* TB = (u16*)(ws + OFF_TB);
    u16* TBS = (u16*)(ws + OFF_TBS);
    float* lm = (float*)(ws + OFF_LAM);
    for (int vb = wk; vb < 256; vb += nwk) {
      const int g = vb >> 3, slice = vb & 7;
      const double dt = exp((double)p.log_dt[g]);
      __syncthreads();
      for (int idx = tix; idx < 64 * 17; idx += 512) {
        int pp = idx / 17, tau = idx % 17;
        double ar = p.a_re[g * 64 + pp], ai = p.a_im[g * 64 + pp];
        double sn, cs, mg = exp((double)tau * ar * dt);
        sincos((double)tau * ai * dt, &sn, &cs);
        lamr[idx] = (float)(mg * cs);
        lami[idx] = (float)(mg * sn);
      }
      if (tix < 64) {
        int pp = tix;
        double ar = p.a_re[g * 64 + pp], ai = p.a_im[g * 64 + pp];
        double sn, cs, mg = exp(ar * dt);
        sincos(ai * dt, &sn, &cs);
        double nr = mg * cs - 1.0, ni = mg * sn, den = ar * ar + ai * ai;
        qre[pp] = (float)((nr * ar + ni * ai) / den);
        qim[pp] = (float)((ni * ar - nr * ai) / den);
      }
      __syncthreads();
      {
        int item = slice * 512 + tix, co = item >> 8, ci = (item >> 4) & 15, tau = item & 15;
        float K = 0.f;
        for (int pp = 0; pp < 64; ++pp) {
          float br = p.b_re[(long)(g * 64 + pp) * 16 + ci], bi = p.b_im[(long)(g * 64 + pp) * 16 + ci];
          float Br = qre[pp] * br - qim[pp] * bi, Bi = qre[pp] * bi + qim[pp] * br;
          float cr = p.c_re[(long)(g * 16 + co) * 64 + pp], cim = p.c_im[(long)(g * 16 + co) * 64 + pp];
          float wr = cr * Br - cim * Bi, wi = cr * Bi + cim * Br;
          K += wr * lamr[pp * 17 + tau] - wi * lami[pp * 17 + tau];
        }
        if (tau == 0 && co == ci) K += p.ssm_d[g * 16 + co];
        u16 kb = f2bf(K);
        for (int t = tau; t < 16; ++t) TB[((long)g * 256 + t * 16 + co) * 384 + (t - tau) * 16 + ci] = kb;
        if (tau >= 1)
          for (int t = 0; t + tau < 16; ++t) TB[((long)g * 256 + t * 16 + co) * 384 + (t + tau) * 16 + ci] = 0;
      }
#pragma unroll 1
      for (int i = 0; i < 4; ++i) {
        int item = slice * 2048 + tix + 512 * i, pp = item >> 8, s_ = (item >> 4) & 15, c = item & 15;
        float lr = lamr[pp * 17 + 15 - s_], li = lami[pp * 17 + 15 - s_];
        float fr = lr * qre[pp] - li * qim[pp], fi = lr * qim[pp] + li * qre[pp];
        float br = p.b_re[(long)(g * 64 + pp) * 16 + c], bi = p.b_im[(long)(g * 64 + pp) * 16 + c];
        EB[((long)g * 128 + pp) * 256 + s_ * 16 + c] = f2bf(fr * br - fi * bi);
        EB[((long)g * 128 + 64 + pp) * 256 + s_ * 16 + c] = f2bf(fr * bi + fi * br);
      }
#pragma unroll 1
      for (int i = 0; i < 4; ++i) {
        int item = slice * 2048 + tix + 512 * i, co = item >> 10, t = (item >> 6) & 15, pp = item & 63;
        float cr = p.c_re[(long)(g * 16 + co) * 64 + pp], cim = p.c_im[(long)(g * 16 + co) * 64 + pp];
        float lr = lamr[pp * 17 + t + 1], li = lami[pp * 17 + t + 1];
        long row = (long)g * 256 + t * 16 + co;
        TB[row * 384 + 256 + pp] = f2bf(cr * lr - cim * li);
        TB[row * 384 + 320 + pp] = f2bf(-(cr * li + cim * lr));
        if (t >= 8) {
          float l2r = lamr[pp * 17 + t - 7], l2i = lami[pp * 17 + t - 7];
          TBS[row * 128 + pp] = f2bf(cr * l2r - cim * l2i);
          TBS[row * 128 + 64 + pp] = f2bf(-(cr * l2i + cim * l2r));
        } else {
          TBS[row * 128 + pp] = 0;
          TBS[row * 128 + 64 + pp] = 0;
        }
      }
      if (slice == 0 && tix < 64) {
        int pp = tix;
        lm[(g * 64 + pp) * 4 + 0] = lamr[pp * 17 + 16];
        lm[(g * 64 + pp) * 4 + 1] = lami[pp * 17 + 16];
        lm[(g * 64 + pp) * 4 + 2] = lamr[pp * 17 + 8];
        lm[(g * 64 + pp) * 4 + 3] = lami[pp * 17 + 8];
      }
    }
    __syncthreads();
  }
}

constexpr int BM = 256, BK = 64, HALF = 128, NXCD = 8, WGM = 8, HT = HALF * BK;

__device__ __forceinline__ int lds_byte(int r, int c) {
  int st = (r >> 4) * 2 + (c >> 5), rr = r & 15, cc = c & 31, ob = rr * 64 + cc * 2;
  return st * 1024 + (ob ^ (((ob >> 9) & 1) << 5));
}
__device__ __forceinline__ void stage_rc(int b, int& R, int& C) {
  int st = b / 1024, sb = b % 1024, swz = sb ^ (((sb >> 9) & 1) << 5);
  R = (st >> 1) * 16 + swz / 64;
  C = (st & 1) * 32 + (swz % 64) / 2;
}

template <class Epi>
__device__ __forceinline__ void gemm_phase(const int tix, const u16* __restrict__ A, const u16* __restrict__ Bt, int M, int N, int K,
                                           const Epi& epi, unsigned char* smem) {
  u16* shm = (u16*)smem;
#define SA(b, h) (shm + ((b)*2 + (h)) * HT)
#define SB(b, h) (shm + (4 + (b)*2 + (h)) * HT)
#define STAGE(P, BASE, br, kt)                                                                       \
  do {                                                                                               \
    const u16* _gb = (BASE) + (long)(br)*K + (long)(kt)*BK;                                          \
    __builtin_amdgcn_global_load_lds((const unsigned*)(_gb + soff0),                                 \
                                     (__attribute__((address_space(3))) unsigned*)((char*)(P) + tix * 16), 16, 0, 0); \
    __builtin_amdgcn_global_load_lds((const unsigned*)(_gb + soff1),                                 \
                                     (__attribute__((address_space(3))) unsigned*)((char*)(P) + tix * 16 + 8192), 16, 0, 0); \
  } while (0)
#define LDA(dst, b, h)                                                                               \
  for (int m = 0; m < 4; ++m)                                                                        \
    for (int k = 0; k < 2; ++k)                                                                      \
  dst[m][k] = *reinterpret_cast<const bf16x8*>((char*)SA(b, h) + lds_byte(wr * 64 + m * 16 + fr, k * 32 + fq * 8))
#define LDB(dst, b, h)                                                                               \
  for (int n = 0; n < 2; ++n)                                                                        \
    for (int k = 0; k < 2; ++k)                                                                      \
  dst[n][k] = *reinterpret_cast<const bf16x8*>((char*)SB(b, h) + lds_byte(wc * 32 + n * 16 + fr, k * 32 + fq * 8))
#define MMA(ai, bj, At, Bt_)                                                                         \
  do {                                                                                               \
    __builtin_amdgcn_s_setprio(1);                                                                   \
    for (int m = 0; m < 4; ++m)                                                                      \
      for (int n = 0; n < 2; ++n)                                                                    \
        for (int k = 0; k < 2; ++k)                                                                  \
          acc[ai][bj][m][n] =                                                                        \
              __builtin_amdgcn_mfma_f32_16x16x32_bf16(At[m][k], Bt_[n][k], acc[ai][bj][m][n], 0, 0, 0); \
    __builtin_amdgcn_s_setprio(0);                                                                   \
  } while (0)
#define WAIT_V(n) asm volatile("s_waitcnt vmcnt(" #n ")" ::: "memory")
#define WAIT_L(n) asm volatile("s_waitcnt lgkmcnt(" #n ")" ::: "memory")
#define BAR __builtin_amdgcn_s_barrier()
#define SCHED __builtin_amdgcn_sched_barrier(0)

  const int nM = M / BM, nN = N / BM, nwg = nM * nN;
  const int wid = tix >> 6, lane = tix & 63, wr = wid >> 2, wc = wid & 3, fr = lane & 15, fq = lane >> 4;
  const int nt = K / BK;
  for (int wg0 = blockIdx.x; wg0 < nwg; wg0 += gridDim.x) {
    unsigned soff0, soff1;
    {
      int tx_ = tix;
      asm volatile("" : "+v"(tx_));
      int r_, c_;
      stage_rc(tx_ * 16, r_, c_);
      soff0 = (unsigned)(r_ * K + c_);
      stage_rc(tx_ * 16 + 8192, r_, c_);
      soff1 = (unsigned)(r_ * K + c_);
    }
    int wgid = wg0;
    {
      int q = nwg / NXCD, r = nwg % NXCD, xcd = wgid % NXCD, off = wgid / NXCD;
      wgid = (xcd < r ? xcd * (q + 1) : r * (q + 1) + (xcd - r) * q) + off;
    }
    int nig = WGM * nN, gid = wgid / nig, fm = gid * WGM, gsz = min(nM - fm, WGM);
    int pm = fm + ((wgid % nig) % gsz), pn = (wgid % nig) / gsz, brow = pm * BM, bcol = pn * BM;
    f32x4 acc[2][2][4][2] = {};
    bf16x8 At[4][2], B0[2][2], B1[2][2];
    STAGE(SB(0, 0), Bt, bcol, 0);
    STAGE(SA(0, 0), A, brow, 0);
    STAGE(SB(0, 1), Bt, bcol + HALF, 0);
    STAGE(SA(0, 1), A, brow + HALF, 0);
    if (wr == 1) BAR;
    WAIT_V(4);
    BAR;
    STAGE(SB(1, 0), Bt, bcol, 1);
    STAGE(SA(1, 0), A, brow, 1);
    STAGE(SB(1, 1), Bt, bcol + HALF, 1);
    WAIT_V(6);
    BAR;
    for (int t = 0; t < nt - 2; t += 2) {
      LDB(B0, 0, 0); SCHED; LDA(At, 0, 0); STAGE(SA(1, 1), A, brow + HALF, t + 1);
      WAIT_L(8); BAR; WAIT_L(0); MMA(0, 0, At, B0); BAR; SCHED;
      LDB(B1, 0, 1); STAGE(SB(0, 0), Bt, bcol, t + 2);
      BAR; WAIT_L(0); MMA(0, 1, At, B1); BAR;
      LDA(At, 0, 1); STAGE(SA(0, 0), A, brow, t + 2);
      BAR; WAIT_L(0); MMA(1, 0, At, B0); BAR; SCHED;
      STAGE(SB(0, 1), Bt, bcol + HALF, t + 2);
      WAIT_V(6); BAR; MMA(1, 1, At, B1); BAR;
      LDB(B0, 1, 0); SCHED; LDA(At, 1, 0); STAGE(SA(0, 1), A, brow + HALF, t + 2);
      WAIT_L(8); BAR; WAIT_L(0); MMA(0, 0, At, B0); BAR; SCHED;
      LDB(B1, 1, 1); STAGE(SB(1, 0), Bt, bcol, t + 3);
      BAR; WAIT_L(0); MMA(0, 1, At, B1); BAR;
      LDA(At, 1, 1); STAGE(SA(1, 0), A, brow, t + 3);
      BAR; WAIT_L(0); MMA(1, 0, At, B0); BAR; SCHED;
      STAGE(SB(1, 1), Bt, bcol + HALF, t + 3);
      WAIT_V(6); BAR; MMA(1, 1, At, B1); BAR;
    }
    {
      LDB(B0, 0, 0); LDA(At, 0, 0); STAGE(SA(1, 1), A, brow + HALF, nt - 1);
      BAR; WAIT_L(0); MMA(0, 0, At, B0); BAR;
      LDB(B1, 0, 1); BAR; WAIT_L(0); MMA(0, 1, At, B1); BAR;
      LDA(At, 0, 1); WAIT_V(4); BAR; WAIT_L(0); MMA(1, 0, At, B0); MMA(1, 1, At, B1); BAR;
    }
    {
      LDB(B0, 1, 0); LDA(At, 1, 0); WAIT_V(2); BAR; WAIT_L(0); MMA(0, 0, At, B0); BAR;
      LDB(B1, 1, 1); WAIT_V(0); BAR; WAIT_L(0); MMA(0, 1, At, B1); BAR;
      LDA(At, 1, 1); BAR; WAIT_L(0); MMA(1, 0, At, B0); MMA(1, 1, At, B1); BAR;
    }
    if (wr == 0) BAR;
    {
      int brow2 = brow, bcol2 = bcol, pn2 = pn;
      asm volatile("" : "+s"(brow2), "+s"(bcol2), "+s"(pn2));
      float* stg = (float*)smem;
#pragma unroll
      for (int ai = 0; ai < 2; ++ai)
#pragma unroll
        for (int mh = 0; mh < 2; ++mh) {
          __syncthreads();
#pragma unroll
          for (int mq = 0; mq < 2; ++mq)
#pragma unroll
            for (int bj = 0; bj < 2; ++bj)
#pragma unroll
              for (int n = 0; n < 2; ++n)
#pragma unroll
                for (int j = 0; j < 4; ++j)
                  stg[(wr * 32 + mq * 16 + fq * 4 + j) * 260 + bj * 128 + wc * 32 + n * 16 + fr] = acc[ai][bj][mh * 2 + mq][n][j];
          __syncthreads();
          if (Epi::UNROLL) {
#pragma unroll
            for (int i = 0; i < 4; ++i) {
              const int lr = (tix >> 5) + 16 * i, c8 = tix & 31;
              const int tr = ai * 128 + (lr >> 5) * 64 + mh * 32 + (lr & 31);
              epi(brow2 + tr, bcol2, pn2, c8, stg + lr * 260);
            }
          } else {
#pragma unroll 1
            for (int i = 0; i < 4; ++i) {
              const int lr = (tix >> 5) + 16 * i, c8 = tix & 31;
              const int tr = ai * 128 + (lr >> 5) * 64 + mh * 32 + (lr & 31);
              epi(brow2 + tr, bcol2, pn2, c8, stg + lr * 260);
            }
          }
        }
    }
    __syncthreads();
  }
#undef SA
#undef SB
#undef STAGE
#undef LDA
#undef LDB
#undef MMA
}

__device__ __forceinline__ void ld8(const float* p, float* v) {
  float4 a = *(const float4*)p, b = *(const float4*)(p + 4);
  v[0] = a.x; v[1] = a.y; v[2] = a.z; v[3] = a.w; v[4] = b.x; v[5] = b.y; v[6] = b.z; v[7] = b.w;
}
__device__ __forceinline__ void st8f(float* p, const float* v) {
  *(float4*)p = make_float4(v[0], v[1], v[2], v[3]);
  *(float4*)(p + 4) = make_float4(v[4], v[5], v[6], v[7]);
}
__device__ __forceinline__ uint4 pack8(const float* v) {
  uint4 o;
  o.x = pack2(v[0], v[1]); o.y = pack2(v[2], v[3]); o.z = pack2(v[4], v[5]); o.w = pack2(v[6], v[7]);
  return o;
}
__device__ __forceinline__ void unpack8(uint4 u, float* v) {
  v[0] = __uint_as_float(u.x << 16); v[1] = __uint_as_float(u.x & 0xffff0000u);
  v[2] = __uint_as_float(u.y << 16); v[3] = __uint_as_float(u.y & 0xffff0000u);
  v[4] = __uint_as_float(u.z << 16); v[5] = __uint_as_float(u.z & 0xffff0000u);
  v[6] = __uint_as_float(u.w << 16); v[7] = __uint_as_float(u.w & 0xffff0000u);
}

struct EpiIn {
  static constexpr bool UNROLL = false;
  const float* b_in; unsigned char* ws; float* out;
  __device__ __forceinline__ void operator()(int row, int bcol, int pn, int c8, const float* srow) const {
    const float* rope = (const float*)(ws + OFF_ROPE);
    u16 *zu = (u16*)(ws + OFF_ZU), *zq = (u16*)(ws + OFF_ZQ), *zk = (u16*)(ws + OFF_ZK), *zv = (u16*)(ws + OFF_ZV),
        *gs = (u16*)(ws + OFF_GS), *ga = (u16*)(ws + OFF_GA);
    const int col = bcol + c8 * 8;
    float v[8], bb[8];
    ld8(srow + c8 * 8, v);
    ld8(b_in + col, bb);
#pragma unroll
    for (int i = 0; i < 8; ++i) v[i] += bb[i];
    if (pn < 2) {
      *(uint4*)(zu + (long)row * 512 + col) = pack8(v);
    } else if (pn < 5) {
      const bool isq = pn < 4, isk = (pn == 4 && c8 < 16);
      const int d0 = (c8 * 8) & 63;
      const bool dorope = (isq || isk) && d0 < 16;
      const int pi = row < NP ? (row & 4095) : (4096 + ((row - NP) & 7));
#pragma unroll
      for (int hf = 0; hf < 2; ++hf) {
        float cs[8];
        ld8(rope + (long)pi * 16 + hf * 8, cs);
#pragma unroll
        for (int i = 0; i < 4; ++i) {
          float x = v[hf * 4 + i];
          float pv = dpp_f<0xB1>(x);
          float r = (d0 == 0) ? (x * cs[2 * i] - pv * cs[2 * i + 1]) : (x * cs[2 * i] + pv * cs[2 * i + 1]);
          v[hf * 4 + i] = dorope ? r : x;
        }
      }
      if (isq) {
        *(uint4*)(zq + (long)row * 512 + (col - 512)) = pack8(v);
      } else {
        const int kk = (c8 & 15) * 8;
        *(uint4*)((isk ? zk : zv) + (long)row * 128 + kk) = pack8(v);
        const long ob = isk ? O_KWP : O_VWP, os = isk ? O_KWS : O_VWS;
        if (row < NP) {
          const int b = row >> 12, t = row & 4095;
          if (t >= 3968) st8f(out + ob + ((long)(b * 128 + t - 3968)) * 128 + kk, v);
        } else {
          const int r = row - NP, b = r >> 3, s = r & 7;
          st8f(out + os + ((long)(b * 128 + 120 + s)) * 128 + kk, v);
        }
      }
    } else {
#pragma unroll
      for (int i = 0; i < 8; ++i) v[i] = sigm(v[i]);
      if (pn < 9) *(uint4*)(gs + (long)row * 1024 + (col - 1280)) = pack8(v);
      else *(uint4*)(ga + (long)row * 1024 + (col - 2304)) = pack8(v);
    }
  }
};

struct EpiGlu {
  static constexpr bool UNROLL = true;
  const float* b_glu; const u16* ma; u16* gs_merged;
  __device__ __forceinline__ void operator()(int row, int bcol, int pn, int c8, const float* srow) const {
    if (c8 >= 16) return;
    const int ca = pn * 128 + c8 * 8;
    float a[8], b[8], ba[8], bb[8], g[8], m[8];
    ld8(srow + c8 * 8, a);
    ld8(srow + 128 + c8 * 8, b);
    ld8(b_glu + ca, ba);
    ld8(b_glu + 1024 + ca, bb);
    unpack8(*(const uint4*)(gs_merged + (long)row * 1024 + ca), g);
    unpack8(*(const uint4*)(ma + (long)row * 1024 + ca), m);
#pragma unroll
    for (int i = 0; i < 8; ++i) a[i] = m[i] + g[i] * ((a[i] + ba[i]) * sigm(b[i] + bb[i]));
    *(uint4*)(gs_merged + (long)row * 1024 + ca) = pack8(a);
  }
};

struct EpiUp {
  static constexpr bool UNROLL = true;
  const u16* ga; u16* ma;
  __device__ __forceinline__ void operator()(int row, int bcol, int pn, int c8, const float* srow) const {
    const long o = (long)row * 1024 + bcol + c8 * 8;
    float v[8], g[8];
    ld8(srow + c8 * 8, v);
    unpack8(*(const uint4*)(ga + o), g);
#pragma unroll
    for (int i = 0; i < 8; ++i) v[i] = g[i] * v[i];
    *(uint4*)(ma + o) = pack8(v);
  }
};

struct EpiOut {
  static constexpr bool UNROLL = true;
  const float *xp, *xs; float* rx;
  __device__ __forceinline__ void operator()(int row, int bcol, int pn, int c8, const float* srow) const {
    const long o = (long)row * 1024 + bcol + c8 * 8;
    float v[8], x[8];
    ld8(srow + c8 * 8, v);
    ld8(row < NP ? xp + o : xs + (o - (long)NP * 1024), x);
#pragma unroll
    for (int i = 0; i < 8; ++i) v[i] = ALPHA * x[i] + v[i];
    st8f(rx + o, v);
  }
};

struct EpiSc {
  static constexpr bool UNROLL = true;
  _Float16* sc;
  __device__ __forceinline__ void operator()(int row, int bcol, int pn, int c8, const float* srow) const {
    float v[8];
    ld8(srow + c8 * 8, v);
    union { uint4 u; _Float16 h[8]; } o;
#pragma unroll
    for (int i = 0; i < 8; ++i) o.h[i] = (_Float16)v[i];
    *(uint4*)(sc + (long)row * 2048 + bcol + c8 * 8) = o.u;
  }
};

__device__ __forceinline__ bf16x8 s5_load_u(const u16* zu, int crow, int g, int s, int ch) {
  const bool smp = crow >= 1024, valid = !smp || s >= 8;
  long tok = smp ? (long)NP + (long)(crow - 1024) * 8 + (s - 8) : (long)crow * 16 + s;
  tok = valid ? tok : 0;
  union { bf16x8 v; uint4 u; } a;
  a.u = *(const uint4*)(zu + tok * 512 + g * 16 + ch);
  const unsigned m = valid ? 0xffffffffu : 0u;
  a.u.x &= m; a.u.y &= m; a.u.z &= m; a.u.w &= m;
  return a.v;
}

__device__ __forceinline__ int s5_tile_row0(int slice, int i) { return i < 8 ? (slice * 8 + i) * 16 : 1024 + slice * 16; }

__device__ __forceinline__ void s5a_item(const int tix, const Params& p, int item) {
  const int g = item >> 3, slice = item & 7;
  const int wid = tix >> 6, lane = tix & 63, r = lane & 15, fq = lane >> 4;
  const u16* zu = (const u16*)(p.ws + OFF_ZU);
  const u16* EB = (const u16*)(p.ws + OFF_EB);
  float* sloc = (float*)(p.ws + OFF_SLOC);
  bf16x8 bfr[8];
#pragma unroll
  for (int kk = 0; kk < 8; ++kk) bfr[kk] = *(const bf16x8*)(EB + ((long)g * 128 + wid * 16 + r) * 256 + kk * 32 + fq * 8);
  bf16x8 a[8], an[8];
#pragma unroll
  for (int kk = 0; kk < 8; ++kk) a[kk] = s5_load_u(zu, s5_tile_row0(slice, 0) + r, g, kk * 2 + (fq >> 1), (fq & 1) * 8);
#pragma unroll 1
  for (int i = 0; i < 9; ++i) {
    const int row0 = s5_tile_row0(slice, i);
    if (i + 1 < 9) {
      const int rown = s5_tile_row0(slice, i + 1);
#pragma unroll
      for (int kk = 0; kk < 8; ++kk) an[kk] = s5_load_u(zu, rown + r, g, kk * 2 + (fq >> 1), (fq & 1) * 8);
    }
    f32x4 acc = {0.f, 0.f, 0.f, 0.f};
#pragma unroll
    for (int kk = 0; kk < 8; ++kk) acc = __builtin_amdgcn_mfma_f32_16x16x32_bf16(a[kk], bfr[kk], acc, 0, 0, 0);
#pragma unroll
    for (int j = 0; j < 4; ++j) sloc[((long)(row0 + fq * 4 + j) * 32 + g) * 128 + wid * 16 + r] = acc[j];
#pragma unroll
    for (int kk = 0; kk < 8; ++kk) a[kk] = an[kk];
  }
}

__device__ __forceinline__ bf16x8 s5c_load_a(const u16* zu, const u16* hin, int crow, int g, int kk, int fq) {
  const bool isu = kk < 8;
  const int s = (kk & 7) * 2 + (fq >> 1), ch = (fq & 1) * 8;
  const bool smp = crow >= 1024, valid = !isu || !smp || s >= 8;
  long tok = smp ? (long)NP + (long)(crow - 1024) * 8 + (s - 8) : (long)crow * 16 + s;
  tok = valid ? tok : 0;
  const u16* pu_ = zu + tok * 512 + g * 16 + ch;
  const u16* ph_ = hin + ((long)crow * 32 + g) * 128 + ((kk - 8) & 3) * 32 + fq * 8;
  union { bf16x8 v; uint4 u; } a;
  a.u = *(const uint4*)(isu ? pu_ : ph_);
  const unsigned m = valid ? 0xffffffffu : 0u;
  a.u.x &= m; a.u.y &= m; a.u.z &= m; a.u.w &= m;
  return a.v;
}

constexpr int S5C_ROWB = 784;
__device__ __forceinline__ void s5c_item(const int tix, const Params& p, int item, unsigned char* smem) {
  const int g = item >> 3, slice = item & 7;
  const int wid = tix >> 6, lane = tix & 63, r = lane & 15, fq = lane >> 4;
  const u16* zu = (const u16*)(p.ws + OFF_ZU);
  const u16* TB = (const u16*)(p.ws + OFF_TB);
  const u16* TBS = (const u16*)(p.ws + OFF_TBS);
  const u16* hin = (const u16*)(p.ws + OFF_HIN);
  u16* hg = (u16*)(p.ws + OFF_HG);
  __syncthreads();
#pragma unroll 1
  for (int hb = 0; hb < 2; ++hb) {
    bf16x8 v[7];
#pragma unroll
    for (int t = 0; t < 7; ++t) {
      int idx = tix + 512 * (hb * 7 + t);
      idx = idx < 6912 ? idx : 6911;
      const int i = idx / 768, rem = idx % 768, rr = rem / 48, pc = rem % 48;
      v[t] = s5c_load_a(zu, hin, s5_tile_row0(slice, i) + rr, g, pc >> 2, pc & 3);
    }
#pragma unroll
    for (int t = 0; t < 7; ++t) {
      int idx = tix + 512 * (hb * 7 + t);
      idx = idx < 6912 ? idx : 6911;
      const int i = idx / 768, rem = idx % 768, rr = rem / 48, pc = rem % 48;
      *(bf16x8*)(smem + (i * 16 + rr) * S5C_ROWB + pc * 16) = v[t];
    }
  }
  bf16x8 bfr[12][2];
#pragma unroll
  for (int kk = 0; kk < 12; ++kk)
#pragma unroll
    for (int q = 0; q < 2; ++q)
      bfr[kk][q] = *(const bf16x8*)(TB + ((long)g * 256 + (wid * 2 + q) * 16 + r) * 384 + kk * 32 + fq * 8);
  __syncthreads();
  bf16x8 a[12];
#pragma unroll 1
  for (int i = 0; i < 9; ++i) {
    const int row0 = s5_tile_row0(slice, i);
#pragma unroll
    for (int kk = 0; kk < 12; ++kk) a[kk] = *(const bf16x8*)(smem + (i * 16 + r) * S5C_ROWB + (kk * 4 + fq) * 16);
    if (i == 8) {
#pragma unroll
      for (int kk = 8; kk < 12; ++kk)
#pragma unroll
        for (int q = 0; q < 2; ++q)
          bfr[kk][q] = *(const bf16x8*)(TBS + ((long)g * 256 + (wid * 2 + q) * 16 + r) * 128 + (kk - 8) * 32 + fq * 8);
    }
    f32x4 acc[2];
    acc[0] = (f32x4){0.f, 0.f, 0.f, 0.f};
    acc[1] = (f32x4){0.f, 0.f, 0.f, 0.f};
#pragma unroll
    for (int kk = 0; kk < 12; ++kk)
#pragma unroll
      for (int q = 0; q < 2; ++q) acc[q] = __builtin_amdgcn_mfma_f32_16x16x32_bf16(a[kk], bfr[kk][q], acc[q], 0, 0, 0);
#pragma unroll
    for (int q = 0; q < 2; ++q) {
      const int nt = wid * 2 + q;
#pragma unroll
      for (int j = 0; j < 4; ++j) {
        const int cr = row0 + fq * 4 + j;
        long tok;
        if (i < 8) tok = (long)cr * 16 + nt;
        else {
          if (nt < 8) continue;
          tok = (long)NP + (long)(cr - 1024) * 8 + (nt - 8);
        }
        hg[tok * 512 + g * 16 + r] = f2bf(gelu_(acc[q][j]));
      }
    }
  }
}

__device__ __forceinline__ void phase_carry(const int tix, const Params& p) {
  const long T = (long)gridDim.x * 512;
  const long tid = (long)blockIdx.x * 512 + tix;
  const float* lm = (const float*)(p.ws + OFF_LAM);
  const float* sloc = (const float*)(p.ws + OFF_SLOC);
  u16* hin = (u16*)(p.ws + OFF_HIN);
  for (long i = tid; i < 262144; i += T) {
    int b = (int)(i / 2048), g = (int)((i / 64) % 32), pp = (int)(i % 64);
    float lr = lm[(g * 64 + pp) * 4 + 2], li = lm[(g * 64 + pp) * 4 + 3];
    float hr = p.st_re[i], hi = p.st_im[i];
    long base = ((long)(1024 + b) * 32 + g) * 128;
    hin[base + pp] = f2bf(hr);
    hin[base + 64 + pp] = f2bf(hi);
    float sr = sloc[base + pp], si = sloc[base + 64 + pp];
    p.out[O_HRS + i] = lr * hr - li * hi + sr;
    p.out[O_HIS + i] = lr * hi + li * hr + si;
  }
  for (long w = (long)(gridDim.x - 1 - blockIdx.x) + (long)gridDim.x * (tix >> 6); w < 128; w += (long)gridDim.x * 8) {
    const int b = (int)(w >> 5), g = (int)(w & 31), pp = tix & 63;
    const long i = (long)(b * 32 + g) * 64 + pp;
    const float lr = lm[(g * 64 + pp) * 4 + 0], li = lm[(g * 64 + pp) * 4 + 1];
    float hr = 0.f, hi = 0.f;
    float ar_[16], ai_[16], br_[16], bi_[16];
#define CLOAD(R, I, c0)                                                      \
  _Pragma("unroll") for (int u = 0; u < 16; ++u) {                           \
    long base = ((long)(b * 256 + (c0) + u) * 32 + g) * 128;                 \
    R[u] = sloc[base + pp];                                                  \
    I[u] = sloc[base + 64 + pp];                                             \
  }
#define CSTEP(R, I, c0)                                                      \
  _Pragma("unroll") for (int u = 0; u < 16; ++u) {                           \
    long base = ((long)(b * 256 + (c0) + u) * 32 + g) * 128;                 \
    hin[base + pp] = f2bf(hr);                                               \
    hin[base + 64 + pp] = f2bf(hi);                                          \
    float nr = lr * hr - li * hi + R[u], ni = lr * hi + li * hr + I[u];      \
    hr = nr;                                                                 \
    hi = ni;                                                                 \
  }
    CLOAD(ar_, ai_, 0)
#pragma unroll 1
    for (int c0 = 0; c0 < 256; c0 += 32) {
      CLOAD(br_, bi_, c0 + 16)
      CSTEP(ar_, ai_, c0)
      if (c0 + 32 < 256) { CLOAD(ar_, ai_, c0 + 32) }
      CSTEP(br_, bi_, c0 + 16)
    }
#undef CLOAD
#undef CSTEP
    p.out[O_HRP + i] = hr;
    p.out[O_HIP + i] = hi;
  }
}

constexpr int KS_STRIDE = 72;
constexpr int VT_STRIDE = 264;

__device__ __forceinline__ void attn_prompt_item(const int tix, const Params& p, int item, unsigned char* smem) {
  const int b = item >> 6, kvh = (item >> 5) & 1, qb = item & 31;
  const int wid = tix >> 6, lane = tix & 63, r = lane & 31, h = lane >> 5;
  const u16* zq = (const u16*)(p.ws + OFF_ZQ);
  const u16* zk = (const u16*)(p.ws + OFF_ZK);
  const u16* zv = (const u16*)(p.ws + OFF_ZV);
  u16* ao = (u16*)(p.ws + OFF_AO);
  u16* Ks = (u16*)smem;
  u16* Vt = (u16*)(smem + 256 * KS_STRIDE * 2);
  const int T0 = qb * 128;
  __syncthreads();
  for (int i = tix; i < 2048; i += 512) {
    int key = i >> 3, seg = i & 7;
    int pos = T0 - 128 + key;
    uint4 kv = {0, 0, 0, 0}, vv = {0, 0, 0, 0};
    if (pos >= 0) {
      long tok = (long)b * 4096 + pos;
      kv = *(const uint4*)(zk + tok * 128 + kvh * 64 + seg * 8);
      vv = *(const uint4*)(zv + tok * 128 + kvh * 64 + seg * 8);
    }
    *(uint4*)(Ks + key * KS_STRIDE + seg * 8) = kv;
    unsigned w[4] = {vv.x, vv.y, vv.z, vv.w};
#pragma unroll
    for (int e = 0; e < 4; ++e) {
      Vt[(seg * 8 + e * 2) * VT_STRIDE + key] = (u16)(w[e] & 0xffff);
      Vt[(seg * 8 + e * 2 + 1) * VT_STRIDE + key] = (u16)(w[e] >> 16);
    }
  }
  __syncthreads();
  const int hq = kvh * 4 + (wid >> 1), qh = wid & 1;
  const float sink = p.sinks[hq];
#pragma unroll 1
  for (int ng = 0; ng < 2; ++ng) {
    const int q0 = qh * 64 + ng * 32, qi = q0 + r;
    const long tok = (long)b * 4096 + T0 + qi;
    bf16x8 qf[4];
#pragma unroll
    for (int kk = 0; kk < 4; ++kk) qf[kk] = *(const bf16x8*)(zq + tok * 512 + hq * 64 + kk * 16 + 8 * h);
    f32x16 oacc[2];
#pragma unroll
    for (int a = 0; a < 2; ++a)
#pragma unroll
      for (int i = 0; i < 16; ++i) oacc[a][i] = 0.f;
    float mrun = sink, lrun = 1.f;
#pragma unroll 1
    for (int kt = 0; kt < 5; ++kt) {
      const int sjb = q0 + kt * 32;
      f32x16 sacc;
#pragma unroll
      for (int i = 0; i < 16; ++i) sacc[i] = 0.f;
#pragma unroll
      for (int kk = 0; kk < 4; ++kk) {
        bf16x8 kf = *(const bf16x8*)(Ks + (sjb + r) * KS_STRIDE + kk * 16 + 8 * h);
        sacc = __builtin_amdgcn_mfma_f32_32x32x16_bf16(kf, qf[kk], sacc, 0, 0, 0);
      }
      float mx = -3.0e38f;
#pragma unroll
      for (int i = 0; i < 16; ++i) {
        int sj = sjb + 8 * (i >> 2) + 4 * h + (i & 3);
        bool valid = (sj > qi) && (sj <= qi + 128) && (qb > 0 || sj >= 128);
        float s = valid ? sacc[i] * 0.125f : -1.0e30f;
        sacc[i] = s;
        mx = fmaxf(mx, s);
      }
      mx = fmaxf(mx, __shfl_xor(mx, 32));
      float mnew = fmaxf(mrun, mx);
      float corr = __expf(mrun - mnew);
      float ls = 0.f;
#pragma unroll
      for (int i = 0; i < 16; ++i) {
        float e = __expf(sacc[i] - mnew);
        sacc[i] = e;
        ls += e;
      }
      ls += __shfl_xor(ls, 32);
      lrun = lrun * corr + ls;
      mrun = mnew;
#pragma unroll
      for (int dt = 0; dt < 2; ++dt)
#pragma unroll
        for (int i = 0; i < 16; ++i) oacc[dt][i] *= corr;
#pragma unroll
      for (int s = 0; s < 2; ++s) {
        union { bf16x8 v; unsigned u[4]; } cv;
#pragma unroll
        for (int e = 0; e < 4; ++e) cv.u[e] = pack2(sacc[8 * s + 2 * e], sacc[8 * s + 2 * e + 1]);
        const int kb = sjb + 16 * s + 4 * h;
#pragma unroll
        for (int dt = 0; dt < 2; ++dt) {
          union { bf16x8 v; uint2 u[2]; } va;
          va.u[0] = *(const uint2*)(Vt + (dt * 32 + r) * VT_STRIDE + kb);
          va.u[1] = *(const uint2*)(Vt + (dt * 32 + r) * VT_STRIDE + kb + 8);
          oacc[dt] = __builtin_amdgcn_mfma_f32_32x32x16_bf16(va.v, cv.v, oacc[dt], 0, 0, 0);
        }
      }
    }
    float inv = 1.f / lrun;
#pragma unroll
    for (int dt = 0; dt < 2; ++dt)
#pragma unroll
      for (int g4 = 0; g4 < 4; ++g4) {
        int d = dt * 32 + 8 * g4 + 4 * h;
        uint2 o;
        o.x = pack2(oacc[dt][4 * g4 + 0] * inv, oacc[dt][4 * g4 + 1] * inv);
        o.y = pack2(oacc[dt][4 * g4 + 2] * inv, oacc[dt][4 * g4 + 3] * inv);
        *(uint2*)(ao + tok * 512 + hq * 64 + d) = o;
      }
  }
}

__device__ __forceinline__ void attn_sample_item(const int tix, const Params& p, int item, unsigned char* smem) {
  const int b = item >> 1, kvh = item & 1;
  const u16* zq = (const u16*)(p.ws + OFF_ZQ);
  const u16* zk = (const u16*)(p.ws + OFF_ZK);
  const u16* zv = (const u16*)(p.ws + OFF_ZV);
  u16* ao = (u16*)(p.ws + OFF_AO);
  float* Kf = (float*)smem;
  float* Vf = Kf + 136 * 68;
  float* Qf = Vf + 136 * 64;
  float* Pf = Qf + 32 * 64;
  __syncthreads();
  for (int i = tix; i < 136 * 16; i += 512) {
    int j = i >> 4, d = (i & 15) * 4;
    float4 kv, vv;
    if (j < 128) {
      kv = *(const float4*)(p.cache_k + ((long)(b * 128 + j) * 2 + kvh) * 64 + d);
      vv = *(const float4*)(p.cache_v + ((long)(b * 128 + j) * 2 + kvh) * 64 + d);
    } else {
      long tok = (long)NP + b * 8 + (j - 128);
      uint2 kw = *(const uint2*)(zk + tok * 128 + kvh * 64 + d), vw = *(const uint2*)(zv + tok * 128 + kvh * 64 + d);
      kv = make_float4(__uint_as_float(kw.x << 16), __uint_as_float(kw.x & 0xffff0000u), __uint_as_float(kw.y << 16), __uint_as_float(kw.y & 0xffff0000u));
      vv = make_float4(__uint_as_float(vw.x << 16), __uint_as_float(vw.x & 0xffff0000u), __uint_as_float(vw.y << 16), __uint_as_float(vw.y & 0xffff0000u));
    }
    *(float4*)(Kf + j * 68 + d) = kv;
    *(float4*)(Vf + j * 64 + d) = vv;
  }
  for (int i = tix; i < 32 * 64; i += 512) {
    int rr = i >> 6, d = i & 63, hl = rr >> 3, s = rr & 7;
    long tok = (long)NP + b * 8 + s;
    Qf[i] = bf2f(zq[tok * 512 + (kvh * 4 + hl) * 64 + d]);
  }
  __syncthreads();
  const int rr = tix >> 4, tt = tix & 15, hl = rr >> 3, s = rr & 7;
  const float sink = p.sinks[kvh * 4 + hl];
  float mx = sink;
  for (int j = tt; j < 136; j += 16) {
    float acc = 0.f;
#pragma unroll
    for (int d = 0; d < 64; d += 4) {
      float4 q = *(const float4*)(Qf + rr * 64 + d), k = *(const float4*)(Kf + j * 68 + d);
      acc += q.x * k.x + q.y * k.y + q.z * k.z + q.w * k.w;
    }
    bool valid = (j > s) && (j <= s + 128);
    float sc = valid ? acc * 0.125f : -1.0e30f;
    Pf[rr * 136 + j] = sc;
    mx = fmaxf(mx, sc);
  }
  for (int o = 8; o >= 1; o >>= 1) mx = fmaxf(mx, __shfl_xor(mx, o));
  float ls = 0.f;
  for (int j = tt; j < 136; j += 16) {
    float e = __expf(Pf[rr * 136 + j] - mx);
    Pf[rr * 136 + j] = e;
    ls += e;
  }
  for (int o = 8; o >= 1; o >>= 1) ls += __shfl_xor(ls, o);
  float inv = 1.f / (ls + __expf(sink - mx));
  __syncthreads();
  float o4[4] = {0.f, 0.f, 0.f, 0.f};
  for (int j = 0; j < 136; ++j) {
    float pj = Pf[rr * 136 + j];
    float4 v = *(const float4*)(Vf + j * 64 + tt * 4);
    o4[0] += pj * v.x; o4[1] += pj * v.y; o4[2] += pj * v.z; o4[3] += pj * v.w;
  }
  long tok = (long)NP + b * 8 + s;
  uint2 o;
  o.x = pack2(o4[0] * inv, o4[1] * inv);
  o.y = pack2(o4[2] * inv, o4[3] * inv);
  *(uint2*)(ao + tok * 512 + (kvh * 4 + hl) * 64 + tt * 4) = o;
}

__device__ __forceinline__ void phase_ln1(const int tix, const Params& p) {
  const int wid = tix >> 6, lane = tix & 63;
  float* rx = (float*)(p.ws + OFF_RX);
  u16* x1b = (u16*)(p.ws + OFF_X1B);
  for (int row = blockIdx.x * 8 + wid; row < NT; row += gridDim.x * 8) {
    float4 v[4];
    float s = 0.f;
#pragma unroll
    for (int i = 0; i < 4; ++i) {
      v[i] = *(const float4*)(rx + (long)row * 1024 + i * 256 + lane * 4);
      s += v[i].x + v[i].y + v[i].z + v[i].w;
    }
    float mu = wave_sum(s) * (1.f / 1024.f);
    float q = 0.f;
#pragma unroll
    for (int i = 0; i < 4; ++i) {
      float a = v[i].x - mu, b = v[i].y - mu, c = v[i].z - mu, d = v[i].w - mu;
      q += a * a + b * b + c * c + d * d;
    }
    float rstd = rsqrtf(wave_sum(q) * (1.f / 1024.f) + 1e-5f);
#pragma unroll
    for (int i = 0; i < 4; ++i) {
      int c = i * 256 + lane * 4;
      float4 g = *(const float4*)(p.ln1_g + c), bb = *(const float4*)(p.ln1_b + c);
      float4 o;
      o.x = (v[i].x - mu) * rstd * g.x + bb.x;
      o.y = (v[i].y - mu) * rstd * g.y + bb.y;
      o.z = (v[i].z - mu) * rstd * g.z + bb.z;
      o.w = (v[i].w - mu) * rstd * g.w + bb.w;
      uint2 ob;
      ob.x = pack2(o.x, o.y);
      ob.y = pack2(o.z, o.w);
      *(uint2*)(x1b + (long)row * 1024 + c) = ob;
    }
  }
}

__device__ __forceinline__ void phase_conv(const int tix, const Params& p, const int wk, const int nwk, const int part) {
  const long T = (long)nwk * 512;
  const long tid = (long)wk * 512 + tix;
  uint4* pu = (uint4*)(p.ws + OFF_PU);
  uint4* pv = (uint4*)(p.ws + OFF_PV);
  for (long i = (long)part * (8192L * 64) + tid; i < (long)(part + 1) * (8192L * 64); i += T) {
    uint4 oa, ob;
    unsigned* wa = (unsigned*)&oa;
    unsigned* wb = (unsigned*)&ob;
#pragma unroll
    for (int q = 0; q < 4; ++q) {
      float4 a = *(const float4*)(p.peer_u + i * 16 + q * 4);
      float4 b = *(const float4*)(p.peer_v + i * 16 + q * 4);
      int w = 0;
      w = __builtin_amdgcn_cvt_pk_fp8_f32(a.x * PU_SCALE, a.y * PU_SCALE, w, false);
      w = __builtin_amdgcn_cvt_pk_fp8_f32(a.z * PU_SCALE, a.w * PU_SCALE, w, true);
      wa[q] = (unsigned)w;
      w = 0;
      w = __builtin_amdgcn_cvt_pk_fp8_f32(b.x * PV_SCALE, b.y * PV_SCALE, w, false);
      w = __builtin_amdgcn_cvt_pk_fp8_f32(b.z * PV_SCALE, b.w * PV_SCALE, w, true);
      wb[q] = (unsigned)w;
    }
    pu[i] = oa;
    pv[i] = ob;
  }
}

__device__ __forceinline__ void sort16_desc(unsigned (&s)[16]) {
  { unsigned hi_ = max(s[0], s[1]), lo_ = min(s[0], s[1]); s[0] = hi_; s[1] = lo_; }
  { unsigned hi_ = max(s[2], s[3]), lo_ = min(s[2], s[3]); s[2] = lo_; s[3] = hi_; }
  { unsigned hi_ = max(s[4], s[5]), lo_ = min(s[4], s[5]); s[4] = hi_; s[5] = lo_; }
  { unsigned hi_ = max(s[6], s[7]), lo_ = min(s[6], s[7]); s[6] = lo_; s[7] = hi_; }
  { unsigned hi_ = max(s[8], s[9]), lo_ = min(s[8], s[9]); s[8] = hi_; s[9] = lo_; }
  { unsigned hi_ = max(s[10], s[11]), lo_ = min(s[10], s[11]); s[10] = lo_; s[11] = hi_; }
  { unsigned hi_ = max(s[12], s[13]), lo_ = min(s[12], s[13]); s[12] = hi_; s[13] = lo_; }
  { unsigned hi_ = max(s[14], s[15]), lo_ = min(s[14], s[15]); s[14] = lo_; s[15] = hi_; }
  { unsigned hi_ = max(s[0], s[2]), lo_ = min(s[0], s[2]); s[0] = hi_; s[2] = lo_; }
  { unsigned hi_ = max(s[1], s[3]), lo_ = min(s[1], s[3]); s[1] = hi_; s[3] = lo_; }
  { unsigned hi_ = max(s[4], s[6]), lo_ = min(s[4], s[6]); s[4] = lo_; s[6] = hi_; }
  { unsigned hi_ = max(s[5], s[7]), lo_ = min(s[5], s[7]); s[5] = lo_; s[7] = hi_; }
  { unsigned hi_ = max(s[8], s[10]), lo_ = min(s[8], s[10]); s[8] = hi_; s[10] = lo_; }
  { unsigned hi_ = max(s[9], s[11]), lo_ = min(s[9], s[11]); s[9] = hi_; s[11] = lo_; }
  { unsigned hi_ = max(s[12], s[14]), lo_ = min(s[12], s[14]); s[12] = lo_; s[14] = hi_; }
  { unsigned hi_ = max(s[13], s[15]), lo_ = min(s[13], s[15]); s[13] = lo_; s[15] = hi_; }
  { unsigned hi_ = max(s[0], s[1]), lo_ = min(s[0], s[1]); s[0] = hi_; s[1] = lo_; }
  { unsigned hi_ = max(s[2], s[3]), lo_ = min(s[2], s[3]); s[2] = hi_; s[3] = lo_; }
  { unsigned hi_ = max(s[4], s[5]), lo_ = min(s[4], s[5]); s[4] = lo_; s[5] = hi_; }
  { unsigned hi_ = max(s[6], s[7]), lo_ = min(s[6], s[7]); s[6] = lo_; s[7] = hi_; }
  { unsigned hi_ = max(s[8], s[9]), lo_ = min(s[8], s[9]); s[8] = hi_; s[9] = lo_; }
  { unsigned hi_ = max(s[10], s[11]), lo_ = min(s[10], s[11]); s[10] = hi_; s[11] = lo_; }
  { unsigned hi_ = max(s[12], s[13]), lo_ = min(s[12], s[13]); s[12] = lo_; s[13] = hi_; }
  { unsigned hi_ = max(s[14], s[15]), lo_ = min(s[14], s[15]); s[14] = lo_; s[15] = hi_; }
  { unsigned hi_ = max(s[0], s[4]), lo_ = min(s[0], s[4]); s[0] = hi_; s[4] = lo_; }
  { unsigned hi_ = max(s[1], s[5]), lo_ = min(s[1], s[5]); s[1] = hi_; s[5] = lo_; }
  { unsigned hi_ = max(s[2], s[6]), lo_ = min(s[2], s[6]); s[2] = hi_; s[6] = lo_; }
  { unsigned hi_ = max(s[3], s[7]), lo_ = min(s[3], s[7]); s[3] = hi_; s[7] = lo_; }
  { unsigned hi_ = max(s[8], s[12]), lo_ = min(s[8], s[12]); s[8] = lo_; s[12] = hi_; }
  { unsigned hi_ = max(s[9], s[13]), lo_ = min(s[9], s[13]); s[9] = lo_; s[13] = hi_; }
  { unsigned hi_ = max(s[10], s[14]), lo_ = min(s[10], s[14]); s[10] = lo_; s[14] = hi_; }
  { unsigned hi_ = max(s[11], s[15]), lo_ = min(s[11], s[15]); s[11] = lo_; s[15] = hi_; }
  { unsigned hi_ = max(s[0], s[2]), lo_ = min(s[0], s[2]); s[0] = hi_; s[2] = lo_; }
  { unsigned hi_ = max(s[1], s[3]), lo_ = min(s[1], s[3]); s[1] = hi_; s[3] = lo_; }
  { unsigned hi_ = max(s[4], s[6]), lo_ = min(s[4], s[6]); s[4] = hi_; s[6] = lo_; }
  { unsigned hi_ = max(s[5], s[7]), lo_ = min(s[5], s[7]); s[5] = hi_; s[7] = lo_; }
  { unsigned hi_ = max(s[8], s[10]), lo_ = min(s[8], s[10]); s[8] = lo_; s[10] = hi_; }
  { unsigned hi_ = max(s[9], s[11]), lo_ = min(s[9], s[11]); s[9] = lo_; s[11] = hi_; }
  { unsigned hi_ = max(s[12], s[14]), lo_ = min(s[12], s[14]); s[12] = lo_; s[14] = hi_; }
  { unsigned hi_ = max(s[13], s[15]), lo_ = min(s[13], s[15]); s[13] = lo_; s[15] = hi_; }
  { unsigned hi_ = max(s[0], s[1]), lo_ = min(s[0], s[1]); s[0] = hi_; s[1] = lo_; }
  { unsigned hi_ = max(s[2], s[3]), lo_ = min(s[2], s[3]); s[2] = hi_; s[3] = lo_; }
  { unsigned hi_ = max(s[4], s[5]), lo_ = min(s[4], s[5]); s[4] = hi_; s[5] = lo_; }
  { unsigned hi_ = max(s[6], s[7]), lo_ = min(s[6], s[7]); s[6] = hi_; s[7] = lo_; }
  { unsigned hi_ = max(s[8], s[9]), lo_ = min(s[8], s[9]); s[8] = lo_; s[9] = hi_; }
  { unsigned hi_ = max(s[10], s[11]), lo_ = min(s[10], s[11]); s[10] = lo_; s[11] = hi_; }
  { unsigned hi_ = max(s[12], s[13]), lo_ = min(s[12], s[13]); s[12] = lo_; s[13] = hi_; }
  { unsigned hi_ = max(s[14], s[15]), lo_ = min(s[14], s[15]); s[14] = lo_; s[15] = hi_; }
  { unsigned hi_ = max(s[0], s[8]), lo_ = min(s[0], s[8]); s[0] = hi_; s[8] = lo_; }
  { unsigned hi_ = max(s[1], s[9]), lo_ = min(s[1], s[9]); s[1] = hi_; s[9] = lo_; }
  { unsigned hi_ = max(s[2], s[10]), lo_ = min(s[2], s[10]); s[2] = hi_; s[10] = lo_; }
  { unsigned hi_ = max(s[3], s[11]), lo_ = min(s[3], s[11]); s[3] = hi_; s[11] = lo_; }
  { unsigned hi_ = max(s[4], s[12]), lo_ = min(s[4], s[12]); s[4] = hi_; s[12] = lo_; }
  { unsigned hi_ = max(s[5], s[13]), lo_ = min(s[5], s[13]); s[5] = hi_; s[13] = lo_; }
  { unsigned hi_ = max(s[6], s[14]), lo_ = min(s[6], s[14]); s[6] = hi_; s[14] = lo_; }
  { unsigned hi_ = max(s[7], s[15]), lo_ = min(s[7], s[15]); s[7] = hi_; s[15] = lo_; }
  { unsigned hi_ = max(s[0], s[4]), lo_ = min(s[0], s[4]); s[0] = hi_; s[4] = lo_; }
  { unsigned hi_ = max(s[1], s[5]), lo_ = min(s[1], s[5]); s[1] = hi_; s[5] = lo_; }
  { unsigned hi_ = max(s[2], s[6]), lo_ = min(s[2], s[6]); s[2] = hi_; s[6] = lo_; }
  { unsigned hi_ = max(s[3], s[7]), lo_ = min(s[3], s[7]); s[3] = hi_; s[7] = lo_; }
  { unsigned hi_ = max(s[8], s[12]), lo_ = min(s[8], s[12]); s[8] = hi_; s[12] = lo_; }
  { unsigned hi_ = max(s[9], s[13]), lo_ = min(s[9], s[13]); s[9] = hi_; s[13] = lo_; }
  { unsigned hi_ = max(s[10], s[14]), lo_ = min(s[10], s[14]); s[10] = hi_; s[14] = lo_; }
  { unsigned hi_ = max(s[11], s[15]), lo_ = min(s[11], s[15]); s[11] = hi_; s[15] = lo_; }
  { unsigned hi_ = max(s[0], s[2]), lo_ = min(s[0], s[2]); s[0] = hi_; s[2] = lo_; }
  { unsigned hi_ = max(s[1], s[3]), lo_ = min(s[1], s[3]); s[1] = hi_; s[3] = lo_; }
  { unsigned hi_ = max(s[4], s[6]), lo_ = min(s[4], s[6]); s[4] = hi_; s[6] = lo_; }
  { unsigned hi_ = max(s[5], s[7]), lo_ = min(s[5], s[7]); s[5] = hi_; s[7] = lo_; }
  { unsigned hi_ = max(s[8], s[10]), lo_ = min(s[8], s[10]); s[8] = hi_; s[10] = lo_; }
  { unsigned hi_ = max(s[9], s[11]), lo_ = min(s[9], s[11]); s[9] = hi_; s[11] = lo_; }
  { unsigned hi_ = max(s[12], s[14]), lo_ = min(s[12], s[14]); s[12] = hi_; s[14] = lo_; }
  { unsigned hi_ = max(s[13], s[15]), lo_ = min(s[13], s[15]); s[13] = hi_; s[15] = lo_; }
  { unsigned hi_ = max(s[0], s[1]), lo_ = min(s[0], s[1]); s[0] = hi_; s[1] = lo_; }
  { unsigned hi_ = max(s[2], s[3]), lo_ = min(s[2], s[3]); s[2] = hi_; s[3] = lo_; }
  { unsigned hi_ = max(s[4], s[5]), lo_ = min(s[4], s[5]); s[4] = hi_; s[5] = lo_; }
  { unsigned hi_ = max(s[6], s[7]), lo_ = min(s[6], s[7]); s[6] = hi_; s[7] = lo_; }
  { unsigned hi_ = max(s[8], s[9]), lo_ = min(s[8], s[9]); s[8] = hi_; s[9] = lo_; }
  { unsigned hi_ = max(s[10], s[11]), lo_ = min(s[10], s[11]); s[10] = hi_; s[11] = lo_; }
  { unsigned hi_ = max(s[12], s[13]), lo_ = min(s[12], s[13]); s[12] = hi_; s[13] = lo_; }
  { unsigned hi_ = max(s[14], s[15]), lo_ = min(s[14], s[15]); s[14] = hi_; s[15] = lo_; }
}
__device__ __forceinline__ void merge16_desc(unsigned (&t)[16], const unsigned (&s)[16]) {
#pragma unroll
  for (int i = 0; i < 16; ++i) t[i] = max(t[i], s[15 - i]);
  { unsigned hi_ = max(t[0], t[8]), lo_ = min(t[0], t[8]); t[0] = hi_; t[8] = lo_; }
  { unsigned hi_ = max(t[1], t[9]), lo_ = min(t[1], t[9]); t[1] = hi_; t[9] = lo_; }
  { unsigned hi_ = max(t[2], t[10]), lo_ = min(t[2], t[10]); t[2] = hi_; t[10] = lo_; }
  { unsigned hi_ = max(t[3], t[11]), lo_ = min(t[3], t[11]); t[3] = hi_; t[11] = lo_; }
  { unsigned hi_ = max(t[4], t[12]), lo_ = min(t[4], t[12]); t[4] = hi_; t[12] = lo_; }
  { unsigned hi_ = max(t[5], t[13]), lo_ = min(t[5], t[13]); t[5] = hi_; t[13] = lo_; }
  { unsigned hi_ = max(t[6], t[14]), lo_ = min(t[6], t[14]); t[6] = hi_; t[14] = lo_; }
  { unsigned hi_ = max(t[7], t[15]), lo_ = min(t[7], t[15]); t[7] = hi_; t[15] = lo_; }
  { unsigned hi_ = max(t[0], t[4]), lo_ = min(t[0], t[4]); t[0] = hi_; t[4] = lo_; }
  { unsigned hi_ = max(t[1], t[5]), lo_ = min(t[1], t[5]); t[1] = hi_; t[5] = lo_; }
  { unsigned hi_ = max(t[2], t[6]), lo_ = min(t[2], t[6]); t[2] = hi_; t[6] = lo_; }
  { unsigned hi_ = max(t[3], t[7]), lo_ = min(t[3], t[7]); t[3] = hi_; t[7] = lo_; }
  { unsigned hi_ = max(t[8], t[12]), lo_ = min(t[8], t[12]); t[8] = hi_; t[12] = lo_; }
  { unsigned hi_ = max(t[9], t[13]), lo_ = min(t[9], t[13]); t[9] = hi_; t[13] = lo_; }
  { unsigned hi_ = max(t[10], t[14]), lo_ = min(t[10], t[14]); t[10] = hi_; t[14] = lo_; }
  { unsigned hi_ = max(t[11], t[15]), lo_ = min(t[11], t[15]); t[11] = hi_; t[15] = lo_; }
  { unsigned hi_ = max(t[0], t[2]), lo_ = min(t[0], t[2]); t[0] = hi_; t[2] = lo_; }
  { unsigned hi_ = max(t[1], t[3]), lo_ = min(t[1], t[3]); t[1] = hi_; t[3] = lo_; }
  { unsigned hi_ = max(t[4], t[6]), lo_ = min(t[4], t[6]); t[4] = hi_; t[6] = lo_; }
  { unsigned hi_ = max(t[5], t[7]), lo_ = min(t[5], t[7]); t[5] = hi_; t[7] = lo_; }
  { unsigned hi_ = max(t[8], t[10]), lo_ = min(t[8], t[10]); t[8] = hi_; t[10] = lo_; }
  { unsigned hi_ = max(t[9], t[11]), lo_ = min(t[9], t[11]); t[9] = hi_; t[11] = lo_; }
  { unsigned hi_ = max(t[12], t[14]), lo_ = min(t[12], t[14]); t[12] = hi_; t[14] = lo_; }
  { unsigned hi_ = max(t[13], t[15]), lo_ = min(t[13], t[15]); t[13] = hi_; t[15] = lo_; }
  { unsigned hi_ = max(t[0], t[1]), lo_ = min(t[0], t[1]); t[0] = hi_; t[1] = lo_; }
  { unsigned hi_ = max(t[2], t[3]), lo_ = min(t[2], t[3]); t[2] = hi_; t[3] = lo_; }
  { unsigned hi_ = max(t[4], t[5]), lo_ = min(t[4], t[5]); t[4] = hi_; t[5] = lo_; }
  { unsigned hi_ = max(t[6], t[7]), lo_ = min(t[6], t[7]); t[6] = hi_; t[7] = lo_; }
  { unsigned hi_ = max(t[8], t[9]), lo_ = min(t[8], t[9]); t[8] = hi_; t[9] = lo_; }
  { unsigned hi_ = max(t[10], t[11]), lo_ = min(t[10], t[11]); t[10] = hi_; t[11] = lo_; }
  { unsigned hi_ = max(t[12], t[13]), lo_ = min(t[12], t[13]); t[12] = hi_; t[13] = lo_; }
  { unsigned hi_ = max(t[14], t[15]), lo_ = min(t[14], t[15]); t[14] = hi_; t[15] = lo_; }
}
__device__ __forceinline__ void topk_insert(const unsigned short* sc, unsigned* t_out) {
  unsigned t[16], s[16];
  uint4 c0 = *(const uint4*)sc, c1 = *(const uint4*)(sc + 8), n0 = c0, n1 = c1;
#pragma unroll 1
  for (int c = 0; c < 8; ++c) {
    if (c + 1 < 8) { n0 = *(const uint4*)(sc + (c + 1) * 16); n1 = *(const uint4*)(sc + (c + 1) * 16 + 8); }
    const unsigned w[8] = {c0.x, c0.y, c0.z, c0.w, c1.x, c1.y, c1.z, c1.w};
#pragma unroll
    for (int e = 0; e < 16; ++e) {
      const unsigned ww = w[e >> 1];
      const unsigned h = (e & 1) ? (ww >> 16) : (ww & 0xffffu);
      const int m = (e & 1) ? ((int)ww >> 31) : ((int)(ww << 16) >> 31);
      const unsigned key = h ^ (0x8000u | ((unsigned)m & 0x7fffu));
      s[e] = (key << 16) | (unsigned)(127 - (c * 16 + e));
    }
    sort16_desc(s);
    if (c == 0) {
#pragma unroll
      for (int i = 0; i < 16; ++i) t[i] = s[i];
    } else {
      merge16_desc(t, s);
    }
    c0 = n0; c1 = n1;
  }
#pragma unroll
  for (int i = 0; i < 16; ++i) t_out[i] = t[i];
}
__device__ __forceinline__ float key_to_f32(unsigned t) {
  unsigned key = t >> 16;
  unsigned h = (key & 0x8000u) ? (key ^ 0x8000u) : (key ^ 0xffffu);
  return (float)__builtin_bit_cast(_Float16, (unsigned short)h);
}

template <int LV>
__device__ __forceinline__ void cand_insert(float vc, float (&tv)[16]) {
#pragma unroll
  for (int k = 0; k < LV; ++k) {
    const float hi = fmaxf(tv[k], vc);
    vc = fminf(tv[k], vc);
    tv[k] = hi;
  }
}

__device__ __forceinline__ void phase_peer(const int tix, const Params& p, unsigned char* smem) {
  const int wid = tix >> 6, lane = tix & 63;
  int* sidx_all = (int*)smem;
  float* sgate_all = (float*)(smem + 34816);
  int* cnt = (int*)(smem + 69632);
  float* sh_all = (float*)(smem + 69632 + 64);
  const unsigned short* SC = (const unsigned short*)(p.ws + OFF_SC);
  const u16* X1B = (const u16*)(p.ws + OFF_X1B);
  const unsigned char* PU = (const unsigned char*)(p.ws + OFF_PU);
  const unsigned char* PV = (const unsigned char*)(p.ws + OFF_PV);
  for (int blk = blockIdx.x; blk < 256; blk += gridDim.x) {
   const int tok0 = blk * 68;
   __syncthreads();
   if (tix == 0) { cnt[0] = 64; cnt[1] = 0; }
   __syncthreads();
#pragma unroll 1
   for (int pass = (wid == 0 ? 0 : 1); pass < 2; ++pass) {
    const int rowbase = pass == 0 ? 512 : wid * 64;
    const int row = rowbase + lane;
    const bool act = row < 544;
    const int rr = act ? row : 0, tl = rr >> 3, hh = rr & 7;
    const unsigned short* sc = SC + (long)(tok0 + tl) * 2048 + hh * 256;
    unsigned t1[16], t2[16];
    topk_insert(sc, t1);
    topk_insert(sc + 128, t2);
    float f1[16], f2[16];
#pragma unroll
    for (int k = 0; k < 16; ++k) { f1[k] = key_to_f32(t1[k]); f2[k] = key_to_f32(t2[k]); }
    int id1[16], id2[16];
#pragma unroll
    for (int k = 0; k < 16; ++k) { id1[k] = (127 - (int)(t1[k] & 0x7fu)) * 128; id2[k] = 127 - (int)(t2[k] & 0x7fu); }
    float tv[16];
#pragma unroll
    for (int k = 0; k < 16; ++k) tv[k] = -INFINITY;
    cand_insert<1>(f1[0] + f2[0], tv);
    cand_insert<2>(f1[0] + f2[1], tv);
    cand_insert<3>(f1[0] + f2[2], tv);
    cand_insert<4>(f1[0] + f2[3], tv);
    cand_insert<5>(f1[0] + f2[4], tv);
    cand_insert<6>(f1[0] + f2[5], tv);
    cand_insert<7>(f1[0] + f2[6], tv);
    cand_insert<8>(f1[0] + f2[7], tv);
    cand_insert<9>(f1[0] + f2[8], tv);
    cand_insert<10>(f1[0] + f2[9], tv);
    cand_insert<11>(f1[0] + f2[10], tv);
    cand_insert<12>(f1[0] + f2[11], tv);
    cand_insert<13>(f1[0] + f2[12], tv);
    cand_insert<14>(f1[0] + f2[13], tv);
    cand_insert<15>(f1[0] + f2[14], tv);
    cand_insert<16>(f1[0] + f2[15], tv);
    cand_insert<16>(f1[1] + f2[0], tv);
    cand_insert<16>(f1[1] + f2[1], tv);
    cand_insert<16>(f1[1] + f2[2], tv);
    cand_insert<16>(f1[1] + f2[3], tv);
    cand_insert<16>(f1[1] + f2[4], tv);
    cand_insert<16>(f1[1] + f2[5], tv);
    cand_insert<16>(f1[1] + f2[6], tv);
    cand_insert<16>(f1[1] + f2[7], tv);
    cand_insert<16>(f1[2] + f2[0], tv);
    cand_insert<16>(f1[2] + f2[1], tv);
    cand_insert<16>(f1[2] + f2[2], tv);
    cand_insert<16>(f1[2] + f2[3], tv);
    cand_insert<16>(f1[2] + f2[4], tv);
    cand_insert<16>(f1[3] + f2[0], tv);
    cand_insert<16>(f1[3] + f2[1], tv);
    cand_insert<16>(f1[3] + f2[2], tv);
    cand_insert<16>(f1[3] + f2[3], tv);
    cand_insert<16>(f1[4] + f2[0], tv);
    cand_insert<16>(f1[4] + f2[1], tv);
    cand_insert<16>(f1[4] + f2[2], tv);
    cand_insert<16>(f1[5] + f2[0], tv);
    cand_insert<16>(f1[5] + f2[1], tv);
    cand_insert<16>(f1[6] + f2[0], tv);
    cand_insert<16>(f1[6] + f2[1], tv);
    cand_insert<16>(f1[7] + f2[0], tv);
    cand_insert<16>(f1[7] + f2[1], tv);
    cand_insert<16>(f1[8] + f2[0], tv);
    cand_insert<16>(f1[9] + f2[0], tv);
    cand_insert<16>(f1[10] + f2[0], tv);
    cand_insert<16>(f1[11] + f2[0], tv);
    cand_insert<16>(f1[12] + f2[0], tv);
    cand_insert<16>(f1[13] + f2[0], tv);
    cand_insert<16>(f1[14] + f2[0], tv);
    cand_insert<16>(f1[15] + f2[0], tv);
    float den = 0.f;
#pragma unroll
    for (int k = 0; k < 16; ++k) den += __expf(tv[k] - tv[0]);
    const float inv = 1.f / den, T = tv[15], top = tv[0];
    int ngt = 0;
    ngt += (f1[0] + f2[0] > T) ? 1 : 0;
    ngt += (f1[0] + f2[1] > T) ? 1 : 0;
    ngt += (f1[0] + f2[2] > T) ? 1 : 0;
    ngt += (f1[0] + f2[3] > T) ? 1 : 0;
    ngt += (f1[0] + f2[4] > T) ? 1 : 0;
    ngt += (f1[0] + f2[5] > T) ? 1 : 0;
    ngt += (f1[0] + f2[6] > T) ? 1 : 0;
    ngt += (f1[0] + f2[7] > T) ? 1 : 0;
    ngt += (f1[0] + f2[8] > T) ? 1 : 0;
    ngt += (f1[0] + f2[9] > T) ? 1 : 0;
    ngt += (f1[0] + f2[10] > T) ? 1 : 0;
    ngt += (f1[0] + f2[11] > T) ? 1 : 0;
    ngt += (f1[0] + f2[12] > T) ? 1 : 0;
    ngt += (f1[0] + f2[13] > T) ? 1 : 0;
    ngt += (f1[0] + f2[14] > T) ? 1 : 0;
    ngt += (f1[0] + f2[15] > T) ? 1 : 0;
    ngt += (f1[1] + f2[0] > T) ? 1 : 0;
    ngt += (f1[1] + f2[1] > T) ? 1 : 0;
    ngt += (f1[1] + f2[2] > T) ? 1 : 0;
    ngt += (f1[1] + f2[3] > T) ? 1 : 0;
    ngt += (f1[1] + f2[4] > T) ? 1 : 0;
    ngt += (f1[1] + f2[5] > T) ? 1 : 0;
    ngt += (f1[1] + f2[6] > T) ? 1 : 0;
    ngt += (f1[1] + f2[7] > T) ? 1 : 0;
    ngt += (f1[2] + f2[0] > T) ? 1 : 0;
    ngt += (f1[2] + f2[1] > T) ? 1 : 0;
    ngt += (f1[2] + f2[2] > T) ? 1 : 0;
    ngt += (f1[2] + f2[3] > T) ? 1 : 0;
    ngt += (f1[2] + f2[4] > T) ? 1 : 0;
    ngt += (f1[3] + f2[0] > T) ? 1 : 0;
    ngt += (f1[3] + f2[1] > T) ? 1 : 0;
    ngt += (f1[3] + f2[2] > T) ? 1 : 0;
    ngt += (f1[3] + f2[3] > T) ? 1 : 0;
    ngt += (f1[4] + f2[0] > T) ? 1 : 0;
    ngt += (f1[4] + f2[1] > T) ? 1 : 0;
    ngt += (f1[4] + f2[2] > T) ? 1 : 0;
    ngt += (f1[5] + f2[0] > T) ? 1 : 0;
    ngt += (f1[5] + f2[1] > T) ? 1 : 0;
    ngt += (f1[6] + f2[0] > T) ? 1 : 0;
    ngt += (f1[6] + f2[1] > T) ? 1 : 0;
    ngt += (f1[7] + f2[0] > T) ? 1 : 0;
    ngt += (f1[7] + f2[1] > T) ? 1 : 0;
    ngt += (f1[8] + f2[0] > T) ? 1 : 0;
    ngt += (f1[9] + f2[0] > T) ? 1 : 0;
    ngt += (f1[10] + f2[0] > T) ? 1 : 0;
    ngt += (f1[11] + f2[0] > T) ? 1 : 0;
    ngt += (f1[12] + f2[0] > T) ? 1 : 0;
    ngt += (f1[13] + f2[0] > T) ? 1 : 0;
    ngt += (f1[14] + f2[0] > T) ? 1 : 0;
    ngt += (f1[15] + f2[0] > T) ? 1 : 0;
    int need = 16 - ngt, pos = 0;
    int* so = sidx_all + tl * 128 + hh * 16;
    float* go = sgate_all + tl * 128 + hh * 16;
#define CAND_EMIT(I, J)                                                        \
    {                                                                          \
      const float vc = f1[I] + f2[J];                                          \
      const bool eq = (vc == T) && (need > 0);                                 \
      const bool sel = (vc > T) || eq;                                         \
      need -= eq ? 1 : 0;                                                      \
      if (sel && act) { so[pos] = id1[I] + id2[J]; go[pos] = __expf(vc - top) * inv; } \
      pos += sel ? 1 : 0;                                                      \
    }
    CAND_EMIT(0, 0)
    CAND_EMIT(0, 1)
    CAND_EMIT(0, 2)
    CAND_EMIT(0, 3)
    CAND_EMIT(0, 4)
    CAND_EMIT(0, 5)
    CAND_EMIT(0, 6)
    CAND_EMIT(0, 7)
    CAND_EMIT(0, 8)
    CAND_EMIT(0, 9)
    CAND_EMIT(0, 10)
    CAND_EMIT(0, 11)
    CAND_EMIT(0, 12)
    CAND_EMIT(0, 13)
    CAND_EMIT(0, 14)
    CAND_EMIT(0, 15)
    CAND_EMIT(1, 0)
    CAND_EMIT(1, 1)
    CAND_EMIT(1, 2)
    CAND_EMIT(1, 3)
    CAND_EMIT(1, 4)
    CAND_EMIT(1, 5)
    CAND_EMIT(1, 6)
    CAND_EMIT(1, 7)
    CAND_EMIT(2, 0)
    CAND_EMIT(2, 1)
    CAND_EMIT(2, 2)
    CAND_EMIT(2, 3)
    CAND_EMIT(2, 4)
    CAND_EMIT(3, 0)
    CAND_EMIT(3, 1)
    CAND_EMIT(3, 2)
    CAND_EMIT(3, 3)
    CAND_EMIT(4, 0)
    CAND_EMIT(4, 1)
    CAND_EMIT(4, 2)
    CAND_EMIT(5, 0)
    CAND_EMIT(5, 1)
    CAND_EMIT(6, 0)
    CAND_EMIT(6, 1)
    CAND_EMIT(7, 0)
    CAND_EMIT(7, 1)
    CAND_EMIT(8, 0)
    CAND_EMIT(9, 0)
    CAND_EMIT(10, 0)
    CAND_EMIT(11, 0)
    CAND_EMIT(12, 0)
    CAND_EMIT(13, 0)
    CAND_EMIT(14, 0)
    CAND_EMIT(15, 0)
#undef CAND_EMIT
    if (pass == 0) {
      asm volatile("s_waitcnt lgkmcnt(0)" ::: "memory");
      if (lane == 0) __hip_atomic_store(&cnt[1], 1, __ATOMIC_RELAXED, __HIP_MEMORY_SCOPE_WORKGROUP);
    }
   }
#pragma unroll 1
   for (int it = 0;; ++it) {
    int tl = wid * 8 + (it & 7);
    int mode = it < 16 ? 1 : 2;
    int cp_lo = it >> 3, cp_hi = it >> 3;
    if (it >= 24) {
      mode = 3; cp_lo = 0; cp_hi = 1;
      tl = 0;
      if (lane == 0) tl = atomicAdd(cnt, 1);
      tl = __builtin_amdgcn_readfirstlane(tl);
      if (tl >= 68) break;
      while (__hip_atomic_load(&cnt[1], __ATOMIC_RELAXED, __HIP_MEMORY_SCOPE_WORKGROUP) == 0) __builtin_amdgcn_s_sleep(1);
    }
    const int tok = tok0 + tl;
    int* sidx = sidx_all + tl * 128;
    float* sgate = sgate_all + tl * 128;
    f32x2 x2[8];
    {
      const uint4* xb_ = (const uint4*)(X1B + (long)tok * 1024 + lane * 16);
      uint4 w0 = xb_[0], w1 = xb_[1];
      unsigned w[8] = {w0.x, w0.y, w0.z, w0.w, w1.x, w1.y, w1.z, w1.w};
#pragma unroll
      for (int i = 0; i < 8; ++i) x2[i] = (f32x2){__uint_as_float(w[i] << 16), __uint_as_float(w[i] & 0xffff0000u)};
    }
    float hv0 = 0.f, hv1 = 0.f;
    uint4 ba[8], bb[8];
#define PLOAD(BUF, TAB, e0)                                                                   \
  _Pragma("unroll") for (int u = 0; u < 8; ++u)                                              \
      BUF[u] = *(const uint4*)(TAB + (long)sidx[(e0) + u] * 1024 + lane * 16);
#define PDOT(BUF, e0)                                                                         \
  _Pragma("unroll") for (int u = 0; u < 8; ++u) {                                            \
    unsigned w[4] = {BUF[u].x, BUF[u].y, BUF[u].z, BUF[u].w};                                 \
    f32x2 s2 = {0.f, 0.f};                                                                    \
    _Pragma("unroll") for (int kk = 0; kk < 4; ++kk) {                                        \
      f32x2 lo = __builtin_amdgcn_cvt_pk_f32_fp8((int)w[kk], false);                          \
      f32x2 hi = __builtin_amdgcn_cvt_pk_f32_fp8((int)w[kk], true);                           \
      s2 += lo * x2[kk * 2];                                                                  \
      s2 += hi * x2[kk * 2 + 1];                                                              \
    }                                                                                         \
    float tot = wsum(s2[0] + s2[1]);                                                          \
    int ee = (e0) + u;                                                                        \
    if (lane == (ee & 63)) { if (ee < 64) hv0 = tot; else hv1 = tot; }                        \
  }
#define PAXPY(BUF, e0)                                                                        \
  _Pragma("unroll") for (int u = 0; u < 8; ++u) {                                            \
    float a = sgate[(e0) + u];                                                                \
    f32x2 a2 = {a, a};                                                                        \
    unsigned w[4] = {BUF[u].x, BUF[u].y, BUF[u].z, BUF[u].w};                                 \
    _Pragma("unroll") for (int kk = 0; kk < 4; ++kk) {                                        \
      f32x2 lo = __builtin_amdgcn_cvt_pk_f32_fp8((int)w[kk], false);                          \
      f32x2 hi = __builtin_amdgcn_cvt_pk_f32_fp8((int)w[kk], true);                           \
      o2[kk * 2] += a2 * lo;                                                                  \
      o2[kk * 2 + 1] += a2 * hi;                                                              \
    }                                                                                         \
  }
    if (mode & 1) {
      float* sh = sh_all + tl * 128;
#pragma unroll 1
      for (int cp = cp_lo; cp <= cp_hi; ++cp) {
        const int colb = cp * 512 + (lane & 31) * 16;
        f32x2 xh[8];
        {
          const uint4* xb_ = (const uint4*)(X1B + (long)tok * 1024 + colb);
          uint4 w0 = xb_[0], w1 = xb_[1];
          unsigned w[8] = {w0.x, w0.y, w0.z, w0.w, w1.x, w1.y, w1.z, w1.w};
#pragma unroll
          for (int i = 0; i < 8; ++i) xh[i] = (f32x2){__uint_as_float(w[i] << 16), __uint_as_float(w[i] & 0xffff0000u)};
        }
#define PLOADU(BUF, e0)                                                                       \
  _Pragma("unroll") for (int u = 0; u < 8; ++u)                                              \
      BUF[u] = *(const uint4*)(PU + (long)sidx[(e0) + 2 * u + (lane >> 5)] * 1024 + colb);
#define PDOTU(BUF, e0)                                                                        \
  _Pragma("unroll") for (int u = 0; u < 8; ++u) {                                            \
    unsigned w[4] = {BUF[u].x, BUF[u].y, BUF[u].z, BUF[u].w};                                 \
    f32x2 s2 = {0.f, 0.f};                                                                    \
    _Pragma("unroll") for (int kk = 0; kk < 4; ++kk) {                                        \
      f32x2 lo = __builtin_amdgcn_cvt_pk_f32_fp8((int)w[kk], false);                          \
      f32x2 hi = __builtin_amdgcn_cvt_pk_f32_fp8((int)w[kk], true);                           \
      s2 += lo * xh[kk * 2];                                                                  \
      s2 += hi * xh[kk * 2 + 1];                                                              \
    }                                                                                         \
    const float v_ = row_sum16(s2[0] + s2[1]);                                                \
    float ta_ = rlane(v_, 0) + rlane(v_, 16), tb_ = rlane(v_, 32) + rlane(v_, 48);            \
    if (lane == 0) {                                                                          \
      if (cp) { ta_ += sh[(e0) + 2 * u]; tb_ += sh[(e0) + 2 * u + 1]; }                       \
      sh[(e0) + 2 * u] = ta_; sh[(e0) + 2 * u + 1] = tb_;                                     \
    }                                                                                         \
  }
        PLOADU(ba, 0)
#pragma unroll 1
        for (int e = 0; e < 128; e += 32) {
          PLOADU(bb, e + 16)
          PDOTU(ba, e)
          if (e + 32 < 128) { PLOADU(ba, e + 32) }
          PDOTU(bb, e + 16)
        }
#undef PLOADU
#undef PDOTU
      }
      if (cp_hi == 1) {
        float g0 = sgate[lane], g1 = sgate[lane + 64];
        sgate[lane] = gelu_(sh[lane] * (1.f / PU_SCALE)) * g0 * (1.f / PV_SCALE);
        sgate[lane + 64] = gelu_(sh[lane + 64] * (1.f / PU_SCALE)) * g1 * (1.f / PV_SCALE);
      }
    }
    if (!(mode & 2)) continue;
    f32x2 o2[8];
#pragma unroll
    for (int i = 0; i < 8; ++i) o2[i] = (f32x2){0.f, 0.f};
    PLOAD(ba, PV, 0)
#pragma unroll 1
    for (int e = 0; e < 128; e += 16) {
      PLOAD(bb, PV, e + 8)
      PAXPY(ba, e)
      if (e + 16 < 128) { PLOAD(ba, PV, e + 16) }
      PAXPY(bb, e + 8)
    }
#undef PLOAD
#undef PDOT
#undef PAXPY
    float o[16];
    float s = 0.f;
#pragma unroll
    for (int i = 0; i < 8; ++i) {
      o[2 * i] = ALPHA * x2[i][0] + o2[i][0];
      o[2 * i + 1] = ALPHA * x2[i][1] + o2[i][1];
      s += o[2 * i] + o[2 * i + 1];
    }
    float mu = wsum(s) * (1.f / 1024.f);
    float q = 0.f;
#pragma unroll
    for (int i = 0; i < 16; ++i) { float dd = o[i] - mu; q += dd * dd; }
    float rstd = rsqrtf(wsum(q) * (1.f / 1024.f) + 1e-5f);
#pragma unroll
    for (int i = 0; i < 4; ++i) {
      int cc = lane * 16 + i * 4;
      float4 g = *(const float4*)(p.ln2_g + cc), bb = *(const float4*)(p.ln2_b + cc);
      float4 y;
      y.x = (o[i * 4] - mu) * rstd * g.x + bb.x;
      y.y = (o[i * 4 + 1] - mu) * rstd * g.y + bb.y;
      y.z = (o[i * 4 + 2] - mu) * rstd * g.z + bb.z;
      y.w = (o[i * 4 + 3] - mu) * rstd * g.w + bb.w;
      __builtin_nontemporal_store(y.x, p.out + O_Y + (long)tok * 1024 + cc);
      __builtin_nontemporal_store(y.y, p.out + O_Y + (long)tok * 1024 + cc + 1);
      __builtin_nontemporal_store(y.z, p.out + O_Y + (long)tok * 1024 + cc + 2);
      __builtin_nontemporal_store(y.w, p.out + O_Y + (long)tok * 1024 + cc + 3);
    }
   }
  }
}

__device__ __forceinline__ Params load_params() {
  Params r;
#if defined(__HIP_DEVICE_COMPILE__)
  typedef const __attribute__((address_space(4))) unsigned long long* KP;
  KP k = (KP)__builtin_amdgcn_kernarg_segment_ptr();
  asm volatile("" : "+s"(k));
  unsigned long long* d = (unsigned long long*)&r;
#pragma unroll
  for (int i = 0; i < (int)(sizeof(Params) / 8); ++i) d[i] = k[i];
#endif
  return r;
}

__device__ __forceinline__ int make_tid(int wave_s) {
  int l;
  asm volatile("v_mbcnt_lo_u32_b32 %0, -1, 0\n\tv_mbcnt_hi_u32_b32 %0, -1, %0" : "=v"(l));
  return wave_s * 64 + l;
}

__global__ void __launch_bounds__(512) mega(Params p_unused, int ph_lo, int ph_hi) {
  extern __shared__ __attribute__((aligned(16))) unsigned char smem[];
  cg::grid_group grid = cg::this_grid();
  __shared__ uint4 xb_words;
  volatile LAS unsigned* xb_st = (volatile LAS unsigned*)&xb_words;
  if (threadIdx.x == 0) {
    xb_words = make_uint4(0u, 0u, 0u, 0u);
    const Params p0 = load_params();
    (void)xb_add(&((unsigned*)(p0.ws + WS_END))[XB_XCNT(xb_xcc_id())], 1u);
  }
  __syncthreads();
  if (ph_hi > 1000) grid.sync();
  const int wave_s = __builtin_amdgcn_readfirstlane((int)threadIdx.x >> 6);

#define PHASE(k, ...)                                                                     \
  if (ph_lo <= (k) && (k) < ph_hi) {                                                      \
    const Params p = load_params();                                                       \
    const int tix = make_tid(wave_s);                                                     \
    unsigned char* ws = p.ws;                                                             \
    { __VA_ARGS__ }                                                                       \
    if ((k) == REP) { __syncthreads(); { __VA_ARGS__ } }                                  \
    if ((k) + 1 < ph_hi) { gbar(tix, (unsigned*)(ws + WS_END), xb_st); } \
  }
#define PHASE_NB(k, ...)                                                                  \
  if (ph_lo <= (k) && (k) < ph_hi) {                                                      \
    const Params p = load_params();                                                       \
    const int tix = make_tid(wave_s);                                                     \
    unsigned char* ws = p.ws;                                                             \
    (void)ws;                                                                             \
    { __VA_ARGS__ }                                                                       \
  }
  PHASE(0, phase_prep(tix, p, smem, 0, blockIdx.x, gridDim.x);)
  PHASE_NB(1, EpiIn e{p.b_in, ws, p.out};
           gemm_phase(tix, (const u16*)(ws + OFF_XB), (const u16*)(ws + OFF_WIN), NT, 3328, 1024, e, smem);)
  PHASE(1, { const int rem = 884 % (int)gridDim.x;
             if (rem == 0) phase_prep(tix, p, smem, 1, blockIdx.x, gridDim.x);
             else if ((int)blockIdx.x >= rem) phase_prep(tix, p, smem, 1, blockIdx.x - rem, gridDim.x - rem); })
  PHASE(2, for (int it = blockIdx.x; it < 256 + 256 + 256; it += gridDim.x) {
             if (it < 256) attn_prompt_item(tix, p, it, smem);
             else if (it < 512) attn_sample_item(tix, p, it - 256, smem);
             else s5a_item(tix, p, it - 512);
           })
  PHASE_NB(3, EpiUp e{(const u16*)(ws + OFF_GA), (u16*)(ws + OFF_MS)};
           gemm_phase(tix, (const u16*)(ws + OFF_AO), (const u16*)(ws + OFF_WUP), NT, 1024, 512, e, smem);)
  PHASE(3, phase_carry(tix, p);)
  PHASE(4, for (int it = blockIdx.x; it < 256; it += gridDim.x) s5c_item(tix, p, it, smem);)
  PHASE(5, EpiGlu e{p.b_glu, (const u16*)(ws + OFF_MS), (u16*)(ws + OFF_GS)};
           gemm_phase(tix, (const u16*)(ws + OFF_HG), (const u16*)(ws + OFF_WGLU), NT, 2048, 512, e, smem);
           { const int rem = 544 % (int)gridDim.x;
             if (rem == 0) phase_conv(tix, p, blockIdx.x, gridDim.x, 0);
             else if ((int)blockIdx.x >= rem) phase_conv(tix, p, blockIdx.x - rem, gridDim.x - rem, 0); })
  PHASE(6, EpiOut e{p.x_prompt, p.x_sample, (float*)(ws + OFF_RX)};
           gemm_phase(tix, (const u16*)(ws + OFF_MERGED), (const u16*)(ws + OFF_WOUT), NT, 1024, 1024, e, smem);
           { const int rem = 272 % (int)gridDim.x;
             if (rem == 0) phase_conv(tix, p, blockIdx.x, gridDim.x, 1);
             else if ((int)blockIdx.x >= rem) phase_conv(tix, p, blockIdx.x - rem, gridDim.x - rem, 1); })
  PHASE(7, phase_ln1(tix, p);)
  PHASE(8, EpiSc e{(_Float16*)(ws + OFF_SC)};
           gemm_phase(tix, (const u16*)(ws + OFF_X1B), (const u16*)(ws + OFF_WPQ), NT, 2048, 1024, e, smem);
           )
  PHASE(9, phase_peer(tix, p, smem);)
}

extern "C" void kernel_launch(void* const* d_in, const int* in_sizes, int n_in, void* d_out, int out_size, void* d_ws,
                              size_t ws_size, hipStream_t stream) {
  static int grid = 0;
  if (grid == 0) {
    if (n_in != 30 || ws_size < WS_END + XCD_BAR_WORDS * 4) {
      fprintf(stderr, "kernel_launch: need 30 inputs and %zu ws bytes; got %d, %zu\n", (size_t)WS_END, n_in, ws_size);
      grid = -1;
      return;
    }
    int dev = 0, cus = 0, per_cu = 0;
    hipGetDevice(&dev);
    hipDeviceGetAttribute(&cus, hipDeviceAttributeMultiprocessorCount, dev);
    if (hipFuncSetAttribute((const void*)mega, hipFuncAttributeMaxDynamicSharedMemorySize, LDS_BYTES) != hipSuccess) {
      fprintf(stderr, "kernel_launch: hipFuncSetAttribute failed\n");
      grid = -1;
      return;
    }
    hipOccupancyMaxActiveBlocksPerMultiprocessor(&per_cu, (const void*)mega, 512, LDS_BYTES);
    if (per_cu < 1) { fprintf(stderr, "kernel_launch: occupancy query says %d\n", per_cu); per_cu = 1; }
    (void)hipGetLastError();
    grid = cus;
  }
  if (grid < 0) return;
  Params p{};
  void** pp = (void**)&p;
  for (int i = 0; i < 30; ++i) pp[i] = d_in[i];
  pp[30] = d_out;
  pp[31] = d_ws;
#if MEGA
  (void)hipMemsetAsync((unsigned char*)d_ws + WS_END, 0, XCD_BAR_WORDS * 4, stream);
  int lo = 0, hi = NPHASE;
  void* args[] = {&p, &lo, &hi};
  hipError_t e = hipLaunchCooperativeKernel((const void*)mega, dim3(grid), dim3(512), args, LDS_BYTES, stream);
  if (e != hipSuccess) fprintf(stderr, "cooperative launch failed: %s (grid %d)\n", hipGetErrorString(e), grid);
#else
  for (int ph = 0; ph < NPHASE; ++ph) {
    hipLaunchKernelGGL(mega, dim3(grid), dim3(512), LDS_BYTES, stream, p, ph, ph + 1);
  }
#endif
}
```

```cpp
#include <hip/hip_runtime.h>
#include <hip/hip_bf16.h>
#include <hip/hip_cooperative_groups.h>
#include <cstdio>
namespace cg = cooperative_groups;

#ifndef MEGA
#define MEGA 1
#endif
#define REP -1

typedef unsigned short u16;
using bf16x8 = __attribute__((ext_vector_type(8))) short;
using bf16x4 = __attribute__((ext_vector_type(4))) short;
using f32x4 = __attribute__((ext_vector_type(4))) float;
using f32x16 = __attribute__((ext_vector_type(16))) float;
using f32x2 = __attribute__((ext_vector_type(2))) float;

constexpr int NP = 16384, NS = 1024, NT = 17408;
constexpr float ALPHA = 1.189207115002721f;
constexpr int NPHASE = 10;
constexpr int LDS_BYTES = 131072;
constexpr float PU_SCALE = 256.f, PV_SCALE = 512.f;

constexpr size_t R0 = 0, R1 = 71303168, R2 = 142606336, R3 = 213909504, R4 = 249561088;
constexpr size_t OFF_XB = R0, OFF_WIN = R0 + 35651584, OFF_EB = R0 + 42467328, OFF_TB = R0 + 44564480,
                 OFF_TBS = R0 + 50855936, OFF_HIN = R0 + 52953088, OFF_MS = R0, OFF_RX = R0;
constexpr size_t OFF_GS = R1, OFF_GA = R1 + 35651584, OFF_MERGED = R1, OFF_PU = R1 + 35651584, OFF_PV = R1 + 35651584 + 16777216;
constexpr size_t OFF_ZU = R2, OFF_ZQ = R2 + 17825792, OFF_ZK = R2 + 35651584, OFF_ZV = R2 + 40108032,
                 OFF_SLOC = R2 + 44564480, OFF_SC = R2;
constexpr size_t OFF_AO = R3, OFF_HG = R3 + 17825792, OFF_X1B = R3;
constexpr size_t OFF_WGLU = R4, OFF_WUP = R4 + 2097152, OFF_WOUT = R4 + 3145728, OFF_WPQ = R4 + 5242880,
                 OFF_ROPE = R4 + 9437184, OFF_LAM = R4 + 9699840, WS_END = R4 + 9732608;

constexpr long O_Y = 0, O_KWP = 17825792, O_VWP = O_KWP + 65536, O_HRP = O_VWP + 65536, O_HIP = O_HRP + 8192,
               O_KWS = O_HIP + 8192, O_VWS = O_KWS + 2097152, O_HRS = O_VWS + 2097152, O_HIS = O_HRS + 262144;

#if defined(__HIP_DEVICE_COMPILE__)
#define GPTR __attribute__((address_space(1)))
#else
#define GPTR
#endif
struct Params {
  const GPTR float *x_prompt, *x_sample, *cache_k, *cache_v, *st_re, *st_im, *w_in, *b_in, *a_re, *a_im, *log_dt, *b_re, *b_im,
      *c_re, *c_im, *ssm_d, *w_glu, *b_glu, *sinks, *w_up, *w_out, *ln1_g, *ln1_b, *peer_wq, *peer_k1, *peer_k2, *peer_u,
      *peer_v, *ln2_g, *ln2_b;
  GPTR float* out;
  GPTR unsigned char* ws;
};

typedef __bf16 hwbf16x2 __attribute__((ext_vector_type(2)));
__device__ __forceinline__ unsigned pack2(float a, float b) {
  const f32x2 f = {a, b};
  const hwbf16x2 v = __builtin_convertvector(f, hwbf16x2);
  return __builtin_bit_cast(unsigned, v);
}
__device__ __forceinline__ u16 f2bf(float f) { return (u16)(pack2(f, 0.f) & 0xffffu); }
__device__ __forceinline__ float bf2f(u16 h) { return __uint_as_float(((unsigned)h) << 16); }
typedef float ntf4 __attribute__((ext_vector_type(4)));
__device__ __forceinline__ float4 ldnt4(const float* p) {
  const ntf4 v = __builtin_nontemporal_load((const ntf4*)p);
  return make_float4(v[0], v[1], v[2], v[3]);
}
__device__ __forceinline__ float sigm(float x) { return __builtin_amdgcn_rcpf(1.f + __expf(-x)); }
__device__ __forceinline__ float gelu_(float x) {
  const float ax = fabsf(x) * 0.70710678118654752f;
  const float t = __builtin_amdgcn_rcpf(1.f + 0.3275911f * ax);
  const float poly = t * (0.254829592f + t * (-0.284496736f + t * (1.421413741f + t * (-1.453152027f + t * 1.061405429f))));
  const float er = copysignf(1.f - poly * __expf(-ax * ax), x);
  return 0.5f * x * (1.f + er);
}
__device__ __forceinline__ float wave_max(float v) {
  for (int o = 32; o >= 1; o >>= 1) v = fmaxf(v, __shfl_xor(v, o));
  return v;
}
__device__ __forceinline__ float wave_sum(float v) {
  for (int o = 32; o >= 1; o >>= 1) v += __shfl_xor(v, o);
  return v;
}


template <int CTRL>
__device__ __forceinline__ float dpp_f(float v) {
  return __int_as_float(__builtin_amdgcn_update_dpp(0, __float_as_int(v), CTRL, 0xf, 0xf, false));
}
__device__ __forceinline__ float row_sum16(float v) {
  v += dpp_f<0x128>(v); v += dpp_f<0x124>(v); v += dpp_f<0x122>(v); v += dpp_f<0x121>(v);
  return v;
}
__device__ __forceinline__ float row_max16(float v) {
  v = fmaxf(v, dpp_f<0x128>(v)); v = fmaxf(v, dpp_f<0x124>(v)); v = fmaxf(v, dpp_f<0x122>(v)); v = fmaxf(v, dpp_f<0x121>(v));
  return v;
}
__device__ __forceinline__ float rlane(float v, int l) { return __int_as_float(__builtin_amdgcn_readlane(__float_as_int(v), l)); }
__device__ __forceinline__ float wsum(float v) {
  v = row_sum16(v);
  return (rlane(v, 0) + rlane(v, 16)) + (rlane(v, 32) + rlane(v, 48));
}
__device__ __forceinline__ int mbcnt64(unsigned long long m) {
  return __builtin_amdgcn_mbcnt_hi((unsigned)(m >> 32), __builtin_amdgcn_mbcnt_lo((unsigned)m, 0));
}
#define XB_TMO      128
#define XB_XCNT(j)  (256  + 64 * (j))
#define XB_XSUB(j)  (1280 + 64 * (j))
#define XB_XGEN(j)  (2304 + 64 * (j))
#define XB_TOP      3328
#define XB_TOPGEN   3392
#define XCD_BAR_WORDS 3456
#define XB_SPIN_CAP (1u << 18)
#define LAS __attribute__((address_space(3)))
__device__ __forceinline__ unsigned xb_ld(unsigned* p) { return __hip_atomic_load(p, __ATOMIC_RELAXED, __HIP_MEMORY_SCOPE_AGENT); }
__device__ __forceinline__ unsigned xb_add(unsigned* p, unsigned v) { return __hip_atomic_fetch_add(p, v, __ATOMIC_RELAXED, __HIP_MEMORY_SCOPE_AGENT); }
__device__ __forceinline__ unsigned xb_xcc_id() { return (unsigned)__builtin_amdgcn_s_getreg((3 << 11) | 20) & 0xFu; }
#define XB_SPIN(cond, bar) do { unsigned _sp = 0; while (cond) { __builtin_amdgcn_s_sleep(1); \
    if ((++_sp & 255u) == 0u) { if (xb_ld(&(bar)[XB_TMO])) break; if (_sp > XB_SPIN_CAP) { atomicAdd(&(bar)[XB_TMO], 1u); break; } } } } while (0)
__device__ __forceinline__ void xcd_barrier_complete(unsigned* bar, unsigned x, unsigned& nloc, unsigned& nx) {
  const unsigned G = gridDim.x;
  unsigned sum, cnt, mine, sp = 0u;
  for (;;) {
    sum = 0u; cnt = 0u; mine = 0u;
#pragma unroll
    for (unsigned j = 0; j < 16; ++j) { const unsigned c = xb_ld(&bar[XB_XCNT(j)]); sum += c; cnt += (c > 0u) ? 1u : 0u; mine = (j == x) ? c : mine; }
    if (sum == G) break;
    __builtin_amdgcn_s_sleep(1);
    if ((++sp & 255u) == 0u) { if (xb_ld(&bar[XB_TMO])) break; if (sp > XB_SPIN_CAP) { atomicAdd(&bar[XB_TMO], 1u); break; } }
  }
  nloc = mine > 0u ? mine : 1u; nx = cnt > 0u ? cnt : 1u;
}
__device__ __forceinline__ void gbar(const int tix, unsigned* bar, volatile LAS unsigned* st) {
  asm volatile("s_waitcnt vmcnt(0)" ::: "memory");
  __syncthreads();
  if (tix == 0) {
    __builtin_amdgcn_s_waitcnt(0);
    const unsigned x = xb_xcc_id();
    unsigned nloc = st[0], nx = st[1];
    if (nloc == 0u) { xcd_barrier_complete(bar, x, nloc, nx); st[0] = nloc; st[1] = nx; }
    const unsigned old = xb_add(&bar[XB_XSUB(x)], 1u);
    const unsigned gen = old / nloc;
    if (old + 1u == (gen + 1u) * nloc) {
      __builtin_amdgcn_fence(__ATOMIC_RELEASE, "agent");
      asm volatile("s_waitcnt vmcnt(0)" ::: "memory");
      const unsigned og = xb_add(&bar[XB_TOP], 1u);
      const unsigned tg = og / nx;
      if (og + 1u == (tg + 1u) * nx) xb_add(&bar[XB_TOPGEN], 1u);
      else XB_SPIN(xb_ld(&bar[XB_TOPGEN]) == tg, bar);
      __builtin_amdgcn_fence(__ATOMIC_ACQUIRE, "agent");
      xb_add(&bar[XB_XGEN(x)], 1u);
      asm volatile("s_waitcnt vmcnt(0)" ::: "memory");
    } else {
      XB_SPIN(xb_ld(&bar[XB_XGEN(x)]) == gen, bar);
      __builtin_amdgcn_fence(__ATOMIC_ACQUIRE, "agent");
      asm volatile("s_waitcnt vmcnt(0)" ::: "memory");
    }
  }
  __syncthreads();
}

__device__ __forceinline__ bf16x8 cvt8(const float* src) {
  float4 a = *(const float4*)src, b = *(const float4*)(src + 4);
  union { bf16x8 v; unsigned u[4]; } c;
  c.u[0] = pack2(a.x, a.y); c.u[1] = pack2(a.z, a.w); c.u[2] = pack2(b.x, b.y); c.u[3] = pack2(b.z, b.w);
  return c.v;
}

__device__ __forceinline__ void phase_prep(const int tix, const Params& p, unsigned char* smem, const int part, const int wk, const int nwk) {
  const long T = (long)nwk * 512;
  const long tid = (long)wk * 512 + tix;
  const int wid = tix >> 6, lane = tix & 63;
  unsigned char* ws = p.ws;
  if (part == 0) {
    u16* xb = (u16*)(ws + OFF_XB);
    for (long i = tid; i < (long)NT * 256; i += T) {
      long e = i * 4;
      const float* src = e < (long)NP * 1024 ? p.x_prompt + e : p.x_sample + (e - (long)NP * 1024);
      float4 v = ldnt4(src);
      uint2 o;
      o.x = pack2(v.x, v.y);
      o.y = pack2(v.z, v.w);
      *(uint2*)(xb + e) = o;
    }
  }
  if (part == 1) {
    for (long i = tid; i < 128L * 3840; i += T) {
      long b = i / 3840, r = (i % 3840) * 4;
      *(float4*)(p.out + O_KWS + b * 16384 + r) = *(const float4*)(p.cache_k + b * 16384 + 1024 + r);
      *(float4*)(p.out + O_VWS + b * 16384 + r) = *(const float4*)(p.cache_v + b * 16384 + 1024 + r);
    }
  }
  if (part == 0) {
    float* rt = (float*)(ws + OFF_ROPE);
    for (long i = tid; i < 4104L * 8; i += T) {
      int pi = (int)(i / 8), f = (int)(i % 8);
      double pos = pi < 4096 ? (double)pi : (double)(8192 + pi - 4096);
      double fr = exp(-log(500000.0) * (double)f / 8.0);
      double s, c;
      sincos(pos * fr, &s, &c);
      rt[i * 2] = (float)c;
      rt[i * 2 + 1] = (float)s;
    }
  }
  {
    float* tile = (float*)smem;
    for (int t = (part == 0 ? wk : 832 + wk); t < (part == 0 ? 832 : 1472); t += nwk) {
      const float* src; u16* dst; int K, N, tt, mode = 0;
      if (t < 832) { src = p.w_in; dst = (u16*)(ws + OFF_WIN); K = 1024; N = 3328; tt = t; }
      else if (t < 1088) { src = p.w_glu; dst = (u16*)(ws + OFF_WGLU); K = 512; N = 2048; tt = t - 832; mode = 1; }
      else if (t < 1216) { src = p.w_up; dst = (u16*)(ws + OFF_WUP); K = 512; N = 1024; tt = t - 1088; }
      else { src = p.w_out; dst = (u16*)(ws + OFF_WOUT); K = 1024; N = 1024; tt = t - 1216; }
      const int ntn = N / 64, kt = tt / ntn, nt_ = tt % ntn;
      __syncthreads();
#pragma unroll
      for (int i = 0; i < 2; ++i) {
        int idx = tix + 512 * i, r = idx >> 4, c4 = idx & 15;
        float4 v = *(const float4*)(src + (long)(kt * 64 + r) * N + nt_ * 64 + c4 * 4);
        tile[r * 65 + c4 * 4] = v.x; tile[r * 65 + c4 * 4 + 1] = v.y; tile[r * 65 + c4 * 4 + 2] = v.z; tile[r * 65 + c4 * 4 + 3] = v.w;
      }
      __syncthreads();
      {
        int n = tix & 63, ks = tix >> 6;
        float f[8];
#pragma unroll
        for (int j = 0; j < 8; ++j) f[j] = tile[(ks * 8 + j) * 65 + n];
        int c = nt_ * 64 + n;
        int row = c;
        if (mode == 1) row = (c < 1024) ? ((c >> 7) * 256 + (c & 127)) : (((c - 1024) >> 7) * 256 + 128 + (c & 127));
        uint4 o;
        o.x = pack2(f[0], f[1]); o.y = pack2(f[2], f[3]); o.z = pack2(f[4], f[5]); o.w = pack2(f[6], f[7]);
        *(uint4*)(dst + (long)row * K + kt * 64 + ks * 8) = o;
      }
    }
    __syncthreads();
  }
  if (part == 1) {
    u16* w = (u16*)(ws + OFF_WPQ);
    const int r = lane & 15, fq = lane >> 4;
    for (int task = wk * 8 + wid; task < 2048; task += nwk * 8) {
      const int ntile = task >> 4, ms = task & 15, n0 = ntile * 16;
      const int h = n0 >> 8, half = (n0 >> 7) & 1, key0 = n0 & 127;
      const float* kp = (half ? p.peer_k2 : p.peer_k1) + (long)(h * 128 + key0 + r) * 64 + fq * 8;
      bf16x8 a0 = cvt8(kp), a1 = cvt8(kp + 32);
#pragma unroll
      for (int mt = 0; mt < 4; ++mt) {
        const int m = ms * 64 + mt * 16 + r;
        const float* wq = p.peer_wq + (long)m * 1024 + h * 128 + half * 64 + fq * 8;
        bf16x8 b0 = cvt8(wq), b1 = cvt8(wq + 32);
        f32x4 acc = {0.f, 0.f, 0.f, 0.f};
        acc = __builtin_amdgcn_mfma_f32_16x16x32_bf16(a0, b0, acc, 0, 0, 0);
        acc = __builtin_amdgcn_mfma_f32_16x16x32_bf16(a1, b1, acc, 0, 0, 0);
#pragma unroll
        for (int j = 0; j < 4; ++j) w[(long)(n0 + fq * 4 + j) * 1024 + m] = f2bf(acc[j]);
      }
    }
  }
  if (part == 1) {
    float* lamr = (float*)smem;
    float* lami = lamr + 64 * 17;
    float* qre = lami + 64 * 17;
    float* qim = qre + 64;
    u16* EB = (u16*)(ws + OFF_EB);
    u16* TB = (u16*)(ws + OFF_TB);
    u16* TBS = (u16*)(ws + OFF_TBS);
    float* lm = (float*)(ws + OFF_LAM);
    for (int vb = wk; vb < 256; vb += nwk) {
      const int g = vb >> 3, slice = vb & 7;
      const double dt = exp((double)p.log_dt[g]);
      __syncthreads();
      for (int idx = tix; idx < 64 * 17; idx += 512) {
        int pp = idx / 17, tau = idx % 17;
        double ar = p.a_re[g * 64 + pp], ai = p.a_im[g * 64 + pp];
        double sn, cs, mg = exp((double)tau * ar * dt);
        sincos((double)tau * ai * dt, &sn, &cs);
        lamr[idx] = (float)(mg * cs);
        lami[idx] = (float)(mg * sn);
      }
      if (tix < 64) {
        int pp = tix;
        double ar = p.a_re[g * 64 + pp], ai = p.a_im[g * 64 + pp];
        double sn, cs, mg = exp(ar * dt);
        sincos(ai * dt, &sn, &cs);
        double nr = mg * cs - 1.0, ni = mg * sn, den = ar * ar + ai * ai;
        qre[pp] = (float)((nr * ar + ni * ai) / den);
        qim[pp] = (float)((ni * ar - nr * ai) / den);
      }
      __syncthreads();
      {
        int item = slice * 512 + tix, co = item >> 8, ci = (item >> 4) & 15, tau = item & 15;
        float K = 0.f;
        for (int pp = 0; pp < 64; ++pp) {
          float br = p.b_re[(long)(g * 64 + pp) * 16 + ci], bi = p.b_im[(long)(g * 64 + pp) * 16 + ci];
          float Br = qre[pp] * br - qim[pp] * bi, Bi = qre[pp] * bi + qim[pp] * br;
          float cr = p.c_re[(long)(g * 16 + co) * 64 + pp], cim = p.c_im[(long)(g * 16 + co) * 64 + pp];
          float wr = cr * Br - cim * Bi, wi = cr * Bi + cim * Br;
          K += wr * lamr[pp * 17 + tau] - wi * lami[pp * 17 + tau];
        }
        if (tau == 0 && co == ci) K += p.ssm_d[g * 16 + co];
        u16 kb = f2bf(K);
        for (int t = tau; t < 16; ++t) TB[((long)g * 256 + t * 16 + co) * 384 + (t - tau) * 16 + ci] = kb;
        if (tau >= 1)
          for (int t = 0; t + tau < 16; ++t) TB[((long)g * 256 + t * 16 + co) * 384 + (t + tau) * 16 + ci] = 0;
      }
#pragma unroll 1
      for (int i = 0; i < 4; ++i) {
        int item = slice * 2048 + tix + 512 * i, pp = item >> 8, s_ = (item >> 4) & 15, c = item & 15;
        float lr = lamr[pp * 17 + 15 - s_], li = lami[pp * 17 + 15 - s_];
        float fr = lr * qre[pp] - li * qim[pp], fi = lr * qim[pp] + li * qre[pp];
        float br = p.b_re[(long)(g * 64 + pp) * 16 + c], bi = p.b_im[(long)(g * 64 + pp) * 16 + c];
        EB[((long)g * 128 + pp) * 256 + s_ * 16 + c] = f2bf(fr * br - fi * bi);
        EB[((long)g * 128 + 64 + pp) * 256 + s_ * 16 + c] = f2bf(fr * bi + fi * br);
      }
#pragma unroll 1
      for (int i = 0; i < 4; ++i) {
        int item = slice * 2048 + tix + 512 * i, co = item >> 10, t = (item >> 6) & 15, pp = item & 63;
        float cr = p.c_re[(long)(g * 16 + co) * 64 + pp], cim = p.c_im[(long)(g * 16 + co) * 64 + pp];
        float lr = lamr[pp * 17 + t + 1], li = lami[pp * 17 + t + 1];
        long row = (long)g * 256 + t * 16 + co;
        TB[row * 384 + 256 + pp] = f2bf(cr * lr - cim * li);
        TB[row * 384 + 320 + pp] = f2bf(-(cr * li + cim * lr));
        if (t >= 8) {
          float l2r = lamr[pp * 17 + t - 7], l2i = lami[pp * 17 + t - 7];
          TBS[row * 128 + pp] = f2bf(cr * l2r - cim * l2i);
          TBS[row * 128 + 64 + pp] = f2bf(-(cr * l2i + cim * l2r));
        } else {
          TBS[row * 128 + pp] = 0;
          TBS[row * 128 + 64 + pp] = 0;
        }
      }
      if (slice == 0 && tix < 64) {
        int pp = tix;
        lm[(g * 64 + pp) * 4 + 0] = lamr[pp * 17 + 16];
        lm[(g * 64 + pp) * 4 + 1] = lami[pp * 17 + 16];
        lm[(g * 64 + pp) * 4 + 2] = lamr[pp * 17 + 8];
        lm[(g * 64 + pp) * 4 + 3] = lami[pp * 17 + 8];
      }
    }
    __syncthreads();
  }
}

constexpr int BM = 256, BK = 64, HALF = 128, NXCD = 8, WGM = 8, HT = HALF * BK;

__device__ __forceinline__ int lds_byte(int r, int c) {
  int st = (r >> 4) * 2 + (c >> 5), rr = r & 15, cc = c & 31, ob = rr * 64 + cc * 2;
  return st * 1024 + (ob ^ (((ob >> 9) & 1) << 5));
}
__device__ __forceinline__ void stage_rc(int b, int& R, int& C) {
  int st = b / 1024, sb = b % 1024, swz = sb ^ (((sb >> 9) & 1) << 5);
  R = (st >> 1) * 16 + swz / 64;
  C = (st & 1) * 32 + (swz % 64) / 2;
}

template <class Epi>
__device__ __forceinline__ void gemm_phase(const int tix, const u16* __restrict__ A, const u16* __restrict__ Bt, int M, int N, int K,
                                           const Epi& epi, unsigned char* smem) {
  u16* shm = (u16*)smem;
#define SA(b, h) (shm + ((b)*2 + (h)) * HT)
#define SB(b, h) (shm + (4 + (b)*2 + (h)) * HT)
#define STAGE(P, BASE, br, kt)                                                                       \
  do {                                                                                               \
    const u16* _gb = (BASE) + (long)(br)*K + (long)(kt)*BK;                                          \
    __builtin_amdgcn_global_load_lds((const unsigned*)(_gb + soff0),                                 \
                                     (__attribute__((address_space(3))) unsigned*)((char*)(P) + tix * 16), 16, 0, 0); \
    __builtin_amdgcn_global_load_lds((const unsigned*)(_gb + soff1),                                 \
                                     (__attribute__((address_space(3))) unsigned*)((char*)(P) + tix * 16 + 8192), 16, 0, 0); \
  } while (0)
#define LDA(dst, b, h)                                                                               \
  for (int m = 0; m < 4; ++m)                                                                        \
    for (int k = 0; k < 2; ++k)                                                                      \
  dst[m][k] = *reinterpret_cast<const bf16x8*>((char*)SA(b, h) + lds_byte(wr * 64 + m * 16 + fr, k * 32 + fq * 8))
#define LDB(dst, b, h)                                                                               \
  for (int n = 0; n < 2; ++n)                                                                        \
    for (int k = 0; k < 2; ++k)                                                                      \
  dst[n][k] = *reinterpret_cast<const bf16x8*>((char*)SB(b, h) + lds_byte(wc * 32 + n * 16 + fr, k * 32 + fq * 8))
#define MMA(ai, bj, At, Bt_)                                                                         \
  do {                                                                                               \
    __builtin_amdgcn_s_setprio(1);                                                                   \
    for (int m = 0; m < 4; ++m)                                                                      \
      for (int n = 0; n < 2; ++n)                                                                    \
        for (int k = 0; k < 2; ++k)                                                                  \
          acc[ai][bj][m][n] =                                                                        \
              __builtin_amdgcn_mfma_f32_16x16x32_bf16(At[m][k], Bt_[n][k], acc[ai][bj][m][n], 0, 0, 0); \
    __builtin_amdgcn_s_setprio(0);                                                                   \
  } while (0)
#define WAIT_V(n) asm volatile("s_waitcnt vmcnt(" #n ")" ::: "memory")
#define WAIT_L(n) asm volatile("s_waitcnt lgkmcnt(" #n ")" ::: "memory")
#define BAR __builtin_amdgcn_s_barrier()
#define SCHED __builtin_amdgcn_sched_barrier(0)

  const int nM = M / BM, nN = N / BM, nwg = nM * nN;
  const int wid = tix >> 6, lane = tix & 63, wr = wid >> 2, wc = wid & 3, fr = lane & 15, fq = lane >> 4;
  const int nt = K / BK;
  for (int wg0 = blockIdx.x; wg0 < nwg; wg0 += gridDim.x) {
    unsigned soff0, soff1;
    {
      int tx_ = tix;
      asm volatile("" : "+v"(tx_));
      int r_, c_;
      stage_rc(tx_ * 16, r_, c_);
      soff0 = (unsigned)(r_ * K + c_);
      stage_rc(tx_ * 16 + 8192, r_, c_);
      soff1 = (unsigned)(r_ * K + c_);
    }
    int wgid = wg0;
    {
      int q = nwg / NXCD, r = nwg % NXCD, xcd = wgid % NXCD, off = wgid / NXCD;
      wgid = (xcd < r ? xcd * (q + 1) : r * (q + 1) + (xcd - r) * q) + off;
    }
    int nig = WGM * nN, gid = wgid / nig, fm = gid * WGM, gsz = min(nM - fm, WGM);
    int pm = fm + ((wgid % nig) % gsz), pn = (wgid % nig) / gsz, brow = pm * BM, bcol = pn * BM;
    f32x4 acc[2][2][4][2] = {};
    bf16x8 At[4][2], B0[2][2], B1[2][2];
    STAGE(SB(0, 0), Bt, bcol, 0);
    STAGE(SA(0, 0), A, brow, 0);
    STAGE(SB(0, 1), Bt, bcol + HALF, 0);
    STAGE(SA(0, 1), A, brow + HALF, 0);
    if (wr == 1) BAR;
    WAIT_V(4);
    BAR;
    STAGE(SB(1, 0), Bt, bcol, 1);
    STAGE(SA(1, 0), A, brow, 1);
    STAGE(SB(1, 1), Bt, bcol + HALF, 1);
    WAIT_V(6);
    BAR;
    for (int t = 0; t < nt - 2; t += 2) {
      LDB(B0, 0, 0); SCHED; LDA(At, 0, 0); STAGE(SA(1, 1), A, brow + HALF, t + 1);
      WAIT_L(8); BAR; WAIT_L(0); MMA(0, 0, At, B0); BAR; SCHED;
      LDB(B1, 0, 1); STAGE(SB(0, 0), Bt, bcol, t + 2);
      BAR; WAIT_L(0); MMA(0, 1, At, B1); BAR;
      LDA(At, 0, 1); STAGE(SA(0, 0), A, brow, t + 2);
      BAR; WAIT_L(0); MMA(1, 0, At, B0); BAR; SCHED;
      STAGE(SB(0, 1), Bt, bcol + HALF, t + 2);
      WAIT_V(6); BAR; MMA(1, 1, At, B1); BAR;
      LDB(B0, 1, 0); SCHED; LDA(At, 1, 0); STAGE(SA(0, 1), A, brow + HALF, t + 2);
      WAIT_L(8); BAR; WAIT_L(0); MMA(0, 0, At, B0); BAR; SCHED;
      LDB(B1, 1, 1); STAGE(SB(1, 0), Bt, bcol, t + 3);
      BAR; WAIT_L(0); MMA(0, 1, At, B1); BAR;
      LDA(At, 1, 1); STAGE(SA(1, 0), A, brow, t + 3);
      BAR; WAIT_L(0); MMA(1, 0, At, B0); BAR; SCHED;
      STAGE(SB(1, 1), Bt, bcol + HALF, t + 3);
      WAIT_V(6); BAR; MMA(1, 1, At, B1); BAR;
    }
    {
      LDB(B0, 0, 0); LDA(At, 0, 0); STAGE(SA(1, 1), A, brow + HALF, nt - 1);
      BAR; WAIT_L(0); MMA(0, 0, At, B0); BAR;
      LDB(B1, 0, 1); BAR; WAIT_L(0); MMA(0, 1, At, B1); BAR;
      LDA(At, 0, 1); WAIT_V(4); BAR; WAIT_L(0); MMA(1, 0, At, B0); MMA(1, 1, At, B1); BAR;
    }
    {
      LDB(B0, 1, 0); LDA(At, 1, 0); WAIT_V(2); BAR; WAIT_L(0); MMA(0, 0, At, B0); BAR;
      LDB(B1, 1, 1); WAIT_V(0); BAR; WAIT_L(0); MMA(0, 1, At, B1); BAR;
      LDA(At, 1, 1); BAR; WAIT_L(0); MMA(1, 0, At, B0); MMA(1, 1, At, B1); BAR;
    }
    if (wr == 0) BAR;
    {
      int brow2 = brow, bcol2 = bcol, pn2 = pn;
      asm volatile("" : "+s"(brow2), "+s"(bcol2), "+s"(pn2));
      float* stg = (float*)smem;
#pragma unroll
      for (int ai = 0; ai < 2; ++ai)
#pragma unroll
        for (int mh = 0; mh < 2; ++mh) {
          __syncthreads();
#pragma unroll
          for (int mq = 0; mq < 2; ++mq)
#pragma unroll
            for (int bj = 0; bj < 2; ++bj)
#pragma unroll
              for (int n = 0; n < 2; ++n)
#pragma unroll
                for (int j = 0; j < 4; ++j)
                  stg[(wr * 32 + mq * 16 + fq * 4 + j) * 260 + bj * 128 + wc * 32 + n * 16 + fr] = acc[ai][bj][mh * 2 + mq][n][j];
          __syncthreads();
          if (Epi::UNROLL) {
#pragma unroll
            for (int i = 0; i < 4; ++i) {
              const int lr = (tix >> 5) + 16 * i, c8 = tix & 31;
              const int tr = ai * 128 + (lr >> 5) * 64 + mh * 32 + (lr & 31);
              epi(brow2 + tr, bcol2, pn2, c8, stg + lr * 260);
            }
          } else {
#pragma unroll 1
            for (int i = 0; i < 4; ++i) {
              const int lr = (tix >> 5) + 16 * i, c8 = tix & 31;
              const int tr = ai * 128 + (lr >> 5) * 64 + mh * 32 + (lr & 31);
              epi(brow2 + tr, bcol2, pn2, c8, stg + lr * 260);
            }
          }
        }
    }
    __syncthreads();
  }
#undef SA
#undef SB
#undef STAGE
#undef LDA
#undef LDB
#undef MMA
}

__device__ __forceinline__ void ld8(const float* p, float* v) {
  float4 a = *(const float4*)p, b = *(const float4*)(p + 4);
  v[0] = a.x; v[1] = a.y; v[2] = a.z; v[3] = a.w; v[4] = b.x; v[5] = b.y; v[6] = b.z; v[7] = b.w;
}
__device__ __forceinline__ void st8f(float* p, const float* v) {
  *(float4*)p = make_float4(v[0], v[1], v[2], v[3]);
  *(float4*)(p + 4) = make_float4(v[4], v[5], v[6], v[7]);
}
__device__ __forceinline__ uint4 pack8(const float* v) {
  uint4 o;
  o.x = pack2(v[0], v[1]); o.y = pack2(v[2], v[3]); o.z = pack2(v[4], v[5]); o.w = pack2(v[6], v[7]);
  return o;
}
__device__ __forceinline__ void unpack8(uint4 u, float* v) {
  v[0] = __uint_as_float(u.x << 16); v[1] = __uint_as_float(u.x & 0xffff0000u);
  v[2] = __uint_as_float(u.y << 16); v[3] = __uint_as_float(u.y & 0xffff0000u);
  v[4] = __uint_as_float(u.z << 16); v[5] = __uint_as_float(u.z & 0xffff0000u);
  v[6] = __uint_as_float(u.w << 16); v[7] = __uint_as_float(u.w & 0xffff0000u);
}

struct EpiIn {
  static constexpr bool UNROLL = false;
  const float* b_in; unsigned char* ws; float* out;
  __device__ __forceinline__ void operator()(int row, int bcol, int pn, int c8, const float* srow) const {
    const float* rope = (const float*)(ws + OFF_ROPE);
    u16 *zu = (u16*)(ws + OFF_ZU), *zq = (u16*)(ws + OFF_ZQ), *zk = (u16*)(ws + OFF_ZK), *zv = (u16*)(ws + OFF_ZV),
        *gs = (u16*)(ws + OFF_GS), *ga = (u16*)(ws + OFF_GA);
    const int col = bcol + c8 * 8;
    float v[8], bb[8];
    ld8(srow + c8 * 8, v);
    ld8(b_in + col, bb);
#pragma unroll
    for (int i = 0; i < 8; ++i) v[i] += bb[i];
    if (pn < 2) {
      *(uint4*)(zu + (long)row * 512 + col) = pack8(v);
    } else if (pn < 5) {
      const bool isq = pn < 4, isk = (pn == 4 && c8 < 16);
      const int d0 = (c8 * 8) & 63;
      const bool dorope = (isq || isk) && d0 < 16;
      const int pi = row < NP ? (row & 4095) : (4096 + ((row - NP) & 7));
#pragma unroll
      for (int hf = 0; hf < 2; ++hf) {
        float cs[8];
        ld8(rope + (long)pi * 16 + hf * 8, cs);
#pragma unroll
        for (int i = 0; i < 4; ++i) {
          float x = v[hf * 4 + i];
          float pv = dpp_f<0xB1>(x);
          float r = (d0 == 0) ? (x * cs[2 * i] - pv * cs[2 * i + 1]) : (x * cs[2 * i] + pv * cs[2 * i + 1]);
          v[hf * 4 + i] = dorope ? r : x;
        }
      }
      if (isq) {
        *(uint4*)(zq + (long)row * 512 + (col - 512)) = pack8(v);
      } else {
        const int kk = (c8 & 15) * 8;
        *(uint4*)((isk ? zk : zv) + (long)row * 128 + kk) = pack8(v);
        const long ob = isk ? O_KWP : O_VWP, os = isk ? O_KWS : O_VWS;
        if (row < NP) {
          const int b = row >> 12, t = row & 4095;
          if (t >= 3968) st8f(out + ob + ((long)(b * 128 + t - 3968)) * 128 + kk, v);
        } else {
          const int r = row - NP, b = r >> 3, s = r & 7;
          st8f(out + os + ((long)(b * 128 + 120 + s)) * 128 + kk, v);
        }
      }
    } else {
#pragma unroll
      for (int i = 0; i < 8; ++i) v[i] = sigm(v[i]);
      if (pn < 9) *(uint4*)(gs + (long)row * 1024 + (col - 1280)) = pack8(v);
      else *(uint4*)(ga + (long)row * 1024 + (col - 2304)) = pack8(v);
    }
  }
};

struct EpiGlu {
  static constexpr bool UNROLL = true;
  const float* b_glu; const u16* ma; u16* gs_merged;
  __device__ __forceinline__ void operator()(int row, int bcol, int pn, int c8, const float* srow) const {
    if (c8 >= 16) return;
    const int ca = pn * 128 + c8 * 8;
    float a[8], b[8], ba[8], bb[8], g[8], m[8];
    ld8(srow + c8 * 8, a);
    ld8(srow + 128 + c8 * 8, b);
    ld8(b_glu + ca, ba);
    ld8(b_glu + 1024 + ca, bb);
    unpack8(*(const uint4*)(gs_merged + (long)row * 1024 + ca), g);
    unpack8(*(const uint4*)(ma + (long)row * 1024 + ca), m);
#pragma unroll
    for (int i = 0; i < 8; ++i) a[i] = m[i] + g[i] * ((a[i] + ba[i]) * sigm(b[i] + bb[i]));
    *(uint4*)(gs_merged + (long)row * 1024 + ca) = pack8(a);
  }
};

struct EpiUp {
  static constexpr bool UNROLL = true;
  const u16* ga; u16* ma;
  __device__ __forceinline__ void operator()(int row, int bcol, int pn, int c8, const float* srow) const {
    const long o = (long)row * 1024 + bcol + c8 * 8;
    float v[8], g[8];
    ld8(srow + c8 * 8, v);
    unpack8(*(const uint4*)(ga + o), g);
#pragma unroll
    for (int i = 0; i < 8; ++i) v[i] = g[i] * v[i];
    *(uint4*)(ma + o) = pack8(v);
  }
};

struct EpiOut {
  static constexpr bool UNROLL = true;
  const float *xp, *xs; u16* rx;
  __device__ __forceinline__ void operator()(int row, int bcol, int pn, int c8, const float* srow) const {
    const long o = (long)row * 1024 + bcol + c8 * 8;
    float v[8], x[8];
    ld8(srow + c8 * 8, v);
    ld8(row < NP ? xp + o : xs + (o - (long)NP * 1024), x);
#pragma unroll
    for (int i = 0; i < 8; ++i) v[i] = ALPHA * x[i] + v[i];
    *(uint4*)(rx + o) = pack8(v);
  }
};

struct EpiSc {
  static constexpr bool UNROLL = true;
  _Float16* sc;
  __device__ __forceinline__ void operator()(int row, int bcol, int pn, int c8, const float* srow) const {
    float v[8];
    ld8(srow + c8 * 8, v);
    union { uint4 u; _Float16 h[8]; } o;
#pragma unroll
    for (int i = 0; i < 8; ++i) o.h[i] = (_Float16)v[i];
    *(uint4*)(sc + (long)row * 2048 + bcol + c8 * 8) = o.u;
  }
};

__device__ __forceinline__ bf16x8 s5_load_u(const u16* zu, int crow, int g, int s, int ch) {
  const bool smp = crow >= 1024, valid = !smp || s >= 8;
  long tok = smp ? (long)NP + (long)(crow - 1024) * 8 + (s - 8) : (long)crow * 16 + s;
  tok = valid ? tok : 0;
  union { bf16x8 v; uint4 u; } a;
  a.u = *(const uint4*)(zu + tok * 512 + g * 16 + ch);
  const unsigned m = valid ? 0xffffffffu : 0u;
  a.u.x &= m; a.u.y &= m; a.u.z &= m; a.u.w &= m;
  return a.v;
}

__device__ __forceinline__ int s5_tile_row0(int slice, int i) { return i < 8 ? (slice * 8 + i) * 16 : 1024 + slice * 16; }

__device__ __forceinline__ void s5a_item(const int tix, const Params& p, int item) {
  const int g = item >> 3, slice = item & 7;
  const int wid = tix >> 6, lane = tix & 63, r = lane & 15, fq = lane >> 4;
  const u16* zu = (const u16*)(p.ws + OFF_ZU);
  const u16* EB = (const u16*)(p.ws + OFF_EB);
  float* sloc = (float*)(p.ws + OFF_SLOC);
  bf16x8 bfr[8];
#pragma unroll
  for (int kk = 0; kk < 8; ++kk) bfr[kk] = *(const bf16x8*)(EB + ((long)g * 128 + wid * 16 + r) * 256 + kk * 32 + fq * 8);
  bf16x8 a[8], an[8];
#pragma unroll
  for (int kk = 0; kk < 8; ++kk) a[kk] = s5_load_u(zu, s5_tile_row0(slice, 0) + r, g, kk * 2 + (fq >> 1), (fq & 1) * 8);
#pragma unroll 1
  for (int i = 0; i < 9; ++i) {
    const int row0 = s5_tile_row0(slice, i);
    if (i + 1 < 9) {
      const int rown = s5_tile_row0(slice, i + 1);
#pragma unroll
      for (int kk = 0; kk < 8; ++kk) an[kk] = s5_load_u(zu, rown + r, g, kk * 2 + (fq >> 1), (fq & 1) * 8);
    }
    f32x4 acc = {0.f, 0.f, 0.f, 0.f};
#pragma unroll
    for (int kk = 0; kk < 8; ++kk) acc = __builtin_amdgcn_mfma_f32_16x16x32_bf16(a[kk], bfr[kk], acc, 0, 0, 0);
#pragma unroll
    for (int j = 0; j < 4; ++j) sloc[((long)(row0 + fq * 4 + j) * 32 + g) * 128 + wid * 16 + r] = acc[j];
#pragma unroll
    for (int kk = 0; kk < 8; ++kk) a[kk] = an[kk];
  }
}

__device__ __forceinline__ bf16x8 s5c_load_a(const u16* zu, const u16* hin, int crow, int g, int kk, int fq) {
  const bool isu = kk < 8;
  const int s = (kk & 7) * 2 + (fq >> 1), ch = (fq & 1) * 8;
  const bool smp = crow >= 1024, valid = !isu || !smp || s >= 8;
  long tok = smp ? (long)NP + (long)(crow - 1024) * 8 + (s - 8) : (long)crow * 16 + s;
  tok = valid ? tok : 0;
  const u16* pu_ = zu + tok * 512 + g * 16 + ch;
  const u16* ph_ = hin + ((long)crow * 32 + g) * 128 + ((kk - 8) & 3) * 32 + fq * 8;
  union { bf16x8 v; uint4 u; } a;
  a.u = *(const uint4*)(isu ? pu_ : ph_);
  const unsigned m = valid ? 0xffffffffu : 0u;
  a.u.x &= m; a.u.y &= m; a.u.z &= m; a.u.w &= m;
  return a.v;
}

constexpr int S5C_ROWB = 784;
__device__ __forceinline__ void s5c_item(const int tix, const Params& p, int item, unsigned char* smem) {
  const int g = item >> 3, slice = item & 7;
  const int wid = tix >> 6, lane = tix & 63, r = lane & 15, fq = lane >> 4;
  const u16* zu = (const u16*)(p.ws + OFF_ZU);
  const u16* TB = (const u16*)(p.ws + OFF_TB);
  const u16* TBS = (const u16*)(p.ws + OFF_TBS);
  const u16* hin = (const u16*)(p.ws + OFF_HIN);
  u16* hg = (u16*)(p.ws + OFF_HG);
  __syncthreads();
#pragma unroll 1
  for (int hb = 0; hb < 2; ++hb) {
    bf16x8 v[7];
#pragma unroll
    for (int t = 0; t < 7; ++t) {
      int idx = tix + 512 * (hb * 7 + t);
      idx = idx < 6912 ? idx : 6911;
      const int i = idx / 768, rem = idx % 768, rr = rem / 48, pc = rem % 48;
      v[t] = s5c_load_a(zu, hin, s5_tile_row0(slice, i) + rr, g, pc >> 2, pc & 3);
    }
#pragma unroll
    for (int t = 0; t < 7; ++t) {
      int idx = tix + 512 * (hb * 7 + t);
      idx = idx < 6912 ? idx : 6911;
      const int i = idx / 768, rem = idx % 768, rr = rem / 48, pc = rem % 48;
      *(bf16x8*)(smem + (i * 16 + rr) * S5C_ROWB + pc * 16) = v[t];
    }
  }
  bf16x8 bfr[12][2];
#pragma unroll
  for (int kk = 0; kk < 12; ++kk)
#pragma unroll
    for (int q = 0; q < 2; ++q)
      bfr[kk][q] = *(const bf16x8*)(TB + ((long)g * 256 + (wid * 2 + q) * 16 + r) * 384 + kk * 32 + fq * 8);
  __syncthreads();
  bf16x8 a[12];
#pragma unroll 1
  for (int i = 0; i < 9; ++i) {
    const int row0 = s5_tile_row0(slice, i);
#pragma unroll
    for (int kk = 0; kk < 12; ++kk) a[kk] = *(const bf16x8*)(smem + (i * 16 + r) * S5C_ROWB + (kk * 4 + fq) * 16);
    if (i == 8) {
#pragma unroll
      for (int kk = 8; kk < 12; ++kk)
#pragma unroll
        for (int q = 0; q < 2; ++q)
          bfr[kk][q] = *(const bf16x8*)(TBS + ((long)g * 256 + (wid * 2 + q) * 16 + r) * 128 + (kk - 8) * 32 + fq * 8);
    }
    f32x4 acc[2];
    acc[0] = (f32x4){0.f, 0.f, 0.f, 0.f};
    acc[1] = (f32x4){0.f, 0.f, 0.f, 0.f};
#pragma unroll
    for (int kk = 0; kk < 12; ++kk)
#pragma unroll
      for (int q = 0; q < 2; ++q) acc[q] = __builtin_amdgcn_mfma_f32_16x16x32_bf16(a[kk], bfr[kk][q], acc[q], 0, 0, 0);
#pragma unroll
    for (int q = 0; q < 2; ++q) {
      const int nt = wid * 2 + q;
#pragma unroll
      for (int j = 0; j < 4; ++j) {
        const int cr = row0 + fq * 4 + j;
        long tok;
        if (i < 8) tok = (long)cr * 16 + nt;
        else {
          if (nt < 8) continue;
          tok = (long)NP + (long)(cr - 1024) * 8 + (nt - 8);
        }
        hg[tok * 512 + g * 16 + r] = f2bf(gelu_(acc[q][j]));
      }
    }
  }
}

__device__ __forceinline__ void phase_carry(const int tix, const Params& p) {
  const long T = (long)gridDim.x * 512;
  const long tid = (long)blockIdx.x * 512 + tix;
  const float* lm = (const float*)(p.ws + OFF_LAM);
  const float* sloc = (const float*)(p.ws + OFF_SLOC);
  u16* hin = (u16*)(p.ws + OFF_HIN);
  for (long i = tid; i < 262144; i += T) {
    int b = (int)(i / 2048), g = (int)((i / 64) % 32), pp = (int)(i % 64);
    float lr = lm[(g * 64 + pp) * 4 + 2], li = lm[(g * 64 + pp) * 4 + 3];
    float hr = p.st_re[i], hi = p.st_im[i];
    long base = ((long)(1024 + b) * 32 + g) * 128;
    hin[base + pp] = f2bf(hr);
    hin[base + 64 + pp] = f2bf(hi);
    float sr = sloc[base + pp], si = sloc[base + 64 + pp];
    p.out[O_HRS + i] = lr * hr - li * hi + sr;
    p.out[O_HIS + i] = lr * hi + li * hr + si;
  }
  for (long w = (long)(gridDim.x - 1 - blockIdx.x) + (long)gridDim.x * (tix >> 6); w < 128; w += (long)gridDim.x * 8) {
    const int b = (int)(w >> 5), g = (int)(w & 31), pp = tix & 63;
    const long i = (long)(b * 32 + g) * 64 + pp;
    const float lr = lm[(g * 64 + pp) * 4 + 0], li = lm[(g * 64 + pp) * 4 + 1];
    float hr = 0.f, hi = 0.f;
    float ar_[16], ai_[16], br_[16], bi_[16];
#define CLOAD(R, I, c0)                                                      \
  _Pragma("unroll") for (int u = 0; u < 16; ++u) {                           \
    long base = ((long)(b * 256 + (c0) + u) * 32 + g) * 128;                 \
    R[u] = sloc[base + pp];                                                  \
    I[u] = sloc[base + 64 + pp];                                             \
  }
#define CSTEP(R, I, c0)                                                      \
  _Pragma("unroll") for (int u = 0; u < 16; ++u) {                           \
    long base = ((long)(b * 256 + (c0) + u) * 32 + g) * 128;                 \
    hin[base + pp] = f2bf(hr);                                               \
    hin[base + 64 + pp] = f2bf(hi);                                          \
    float nr = lr * hr - li * hi + R[u], ni = lr * hi + li * hr + I[u];      \
    hr = nr;                                                                 \
    hi = ni;                                                                 \
  }
    CLOAD(ar_, ai_, 0)
#pragma unroll 1
    for (int c0 = 0; c0 < 256; c0 += 32) {
      CLOAD(br_, bi_, c0 + 16)
      CSTEP(ar_, ai_, c0)
      if (c0 + 32 < 256) { CLOAD(ar_, ai_, c0 + 32) }
      CSTEP(br_, bi_, c0 + 16)
    }
#undef CLOAD
#undef CSTEP
    p.out[O_HRP + i] = hr;
    p.out[O_HIP + i] = hi;
  }
}

constexpr int KS_STRIDE = 72;
constexpr int VT_STRIDE = 264;

__device__ __forceinline__ void attn_prompt_item(const int tix, const Params& p, int item, unsigned char* smem) {
  const int b = item >> 6, kvh = (item >> 5) & 1, qb = item & 31;
  const int wid = tix >> 6, lane = tix & 63, r = lane & 31, h = lane >> 5;
  const u16* zq = (const u16*)(p.ws + OFF_ZQ);
  const u16* zk = (const u16*)(p.ws + OFF_ZK);
  const u16* zv = (const u16*)(p.ws + OFF_ZV);
  u16* ao = (u16*)(p.ws + OFF_AO);
  u16* Ks = (u16*)smem;
  u16* Vt = (u16*)(smem + 256 * KS_STRIDE * 2);
  const int T0 = qb * 128;
  __syncthreads();
  for (int i = tix; i < 2048; i += 512) {
    int key = i >> 3, seg = i & 7;
    int pos = T0 - 128 + key;
    uint4 kv = {0, 0, 0, 0}, vv = {0, 0, 0, 0};
    if (pos >= 0) {
      long tok = (long)b * 4096 + pos;
      kv = *(const uint4*)(zk + tok * 128 + kvh * 64 + seg * 8);
      vv = *(const uint4*)(zv + tok * 128 + kvh * 64 + seg * 8);
    }
    *(uint4*)(Ks + key * KS_STRIDE + seg * 8) = kv;
    unsigned w[4] = {vv.x, vv.y, vv.z, vv.w};
#pragma unroll
    for (int e = 0; e < 4; ++e) {
      Vt[(seg * 8 + e * 2) * VT_STRIDE + key] = (u16)(w[e] & 0xffff);
      Vt[(seg * 8 + e * 2 + 1) * VT_STRIDE + key] = (u16)(w[e] >> 16);
    }
  }
  __syncthreads();
  const int hq = kvh * 4 + (wid >> 1), qh = wid & 1;
  const float sink = p.sinks[hq];
#pragma unroll 1
  for (int ng = 0; ng < 2; ++ng) {
    const int q0 = qh * 64 + ng * 32, qi = q0 + r;
    const long tok = (long)b * 4096 + T0 + qi;
    bf16x8 qf[4];
#pragma unroll
    for (int kk = 0; kk < 4; ++kk) qf[kk] = *(const bf16x8*)(zq + tok * 512 + hq * 64 + kk * 16 + 8 * h);
    f32x16 oacc[2];
#pragma unroll
    for (int a = 0; a < 2; ++a)
#pragma unroll
      for (int i = 0; i < 16; ++i) oacc[a][i] = 0.f;
    float mrun = sink, lrun = 1.f;
#pragma unroll 1
    for (int kt = 0; kt < 5; ++kt) {
      const int sjb = q0 + kt * 32;
      f32x16 sacc;
#pragma unroll
      for (int i = 0; i < 16; ++i) sacc[i] = 0.f;
#pragma unroll
      for (int kk = 0; kk < 4; ++kk) {
        bf16x8 kf = *(const bf16x8*)(Ks + (sjb + r) * KS_STRIDE + kk * 16 + 8 * h);
        sacc = __builtin_amdgcn_mfma_f32_32x32x16_bf16(kf, qf[kk], sacc, 0, 0, 0);
      }
      float mx = -3.0e38f;
#pragma unroll
      for (int i = 0; i < 16; ++i) {
        int sj = sjb + 8 * (i >> 2) + 4 * h + (i & 3);
        bool valid = (sj > qi) && (sj <= qi + 128) && (qb > 0 || sj >= 128);
        float s = valid ? sacc[i] * 0.125f : -1.0e30f;
        sacc[i] = s;
        mx = fmaxf(mx, s);
      }
      mx = fmaxf(mx, __shfl_xor(mx, 32));
      float mnew = fmaxf(mrun, mx);
      float corr = __expf(mrun - mnew);
      float ls = 0.f;
#pragma unroll
      for (int i = 0; i < 16; ++i) {
        float e = __expf(sacc[i] - mnew);
        sacc[i] = e;
        ls += e;
      }
      ls += __shfl_xor(ls, 32);
      lrun = lrun * corr + ls;
      mrun = mnew;
#pragma unroll
      for (int dt = 0; dt < 2; ++dt)
#pragma unroll
        for (int i = 0; i < 16; ++i) oacc[dt][i] *= corr;
#pragma unroll
      for (int s = 0; s < 2; ++s) {
        union { bf16x8 v; unsigned u[4]; } cv;
#pragma unroll
        for (int e = 0; e < 4; ++e) cv.u[e] = pack2(sacc[8 * s + 2 * e], sacc[8 * s + 2 * e + 1]);
        const int kb = sjb + 16 * s + 4 * h;
#pragma unroll
        for (int dt = 0; dt < 2; ++dt) {
          union { bf16x8 v; uint2 u[2]; } va;
          va.u[0] = *(const uint2*)(Vt + (dt * 32 + r) * VT_STRIDE + kb);
          va.u[1] = *(const uint2*)(Vt + (dt * 32 + r) * VT_STRIDE + kb + 8);
          oacc[dt] = __builtin_amdgcn_mfma_f32_32x32x16_bf16(va.v, cv.v, oacc[dt], 0, 0, 0);
        }
      }
    }
    float inv = 1.f / lrun;
#pragma unroll
    for (int dt = 0; dt < 2; ++dt)
#pragma unroll
      for (int g4 = 0; g4 < 4; ++g4) {
        int d = dt * 32 + 8 * g4 + 4 * h;
        uint2 o;
        o.x = pack2(oacc[dt][4 * g4 + 0] * inv, oacc[dt][4 * g4 + 1] * inv);
        o.y = pack2(oacc[dt][4 * g4 + 2] * inv, oacc[dt][4 * g4 + 3] * inv);
        *(uint2*)(ao + tok * 512 + hq * 64 + d) = o;
      }
  }
}

__device__ __forceinline__ void attn_sample_item(const int tix, const Params& p, int item, unsigned char* smem) {
  const int b = item >> 1, kvh = item & 1;
  const u16* zq = (const u16*)(p.ws + OFF_ZQ);
  const u16* zk = (const u16*)(p.ws + OFF_ZK);
  const u16* zv = (const u16*)(p.ws + OFF_ZV);
  u16* ao = (u16*)(p.ws + OFF_AO);
  float* Kf = (float*)smem;
  float* Vf = Kf + 136 * 68;
  float* Qf = Vf + 136 * 64;
  float* Pf = Qf + 32 * 64;
  __syncthreads();
  for (int i = tix; i < 136 * 16; i += 512) {
    int j = i >> 4, d = (i & 15) * 4;
    float4 kv, vv;
    if (j < 128) {
      kv = *(const float4*)(p.cache_k + ((long)(b * 128 + j) * 2 + kvh) * 64 + d);
      vv = *(const float4*)(p.cache_v + ((long)(b * 128 + j) * 2 + kvh) * 64 + d);
    } else {
      long tok = (long)NP + b * 8 + (j - 128);
      uint2 kw = *(const uint2*)(zk + tok * 128 + kvh * 64 + d), vw = *(const uint2*)(zv + tok * 128 + kvh * 64 + d);
      kv = make_float4(__uint_as_float(kw.x << 16), __uint_as_float(kw.x & 0xffff0000u), __uint_as_float(kw.y << 16), __uint_as_float(kw.y & 0xffff0000u));
      vv = make_float4(__uint_as_float(vw.x << 16), __uint_as_float(vw.x & 0xffff0000u), __uint_as_float(vw.y << 16), __uint_as_float(vw.y & 0xffff0000u));
    }
    *(float4*)(Kf + j * 68 + d) = kv;
    *(float4*)(Vf + j * 64 + d) = vv;
  }
  for (int i = tix; i < 32 * 64; i += 512) {
    int rr = i >> 6, d = i & 63, hl = rr >> 3, s = rr & 7;
    long tok = (long)NP + b * 8 + s;
    Qf[i] = bf2f(zq[tok * 512 + (kvh * 4 + hl) * 64 + d]);
  }
  __syncthreads();
  const int rr = tix >> 4, tt = tix & 15, hl = rr >> 3, s = rr & 7;
  const float sink = p.sinks[kvh * 4 + hl];
  float mx = sink;
  for (int j = tt; j < 136; j += 16) {
    float acc = 0.f;
#pragma unroll
    for (int d = 0; d < 64; d += 4) {
      float4 q = *(const float4*)(Qf + rr * 64 + d), k = *(const float4*)(Kf + j * 68 + d);
      acc += q.x * k.x + q.y * k.y + q.z * k.z + q.w * k.w;
    }
    bool valid = (j > s) && (j <= s + 128);
    float sc = valid ? acc * 0.125f : -1.0e30f;
    Pf[rr * 136 + j] = sc;
    mx = fmaxf(mx, sc);
  }
  for (int o = 8; o >= 1; o >>= 1) mx = fmaxf(mx, __shfl_xor(mx, o));
  float ls = 0.f;
  for (int j = tt; j < 136; j += 16) {
    float e = __expf(Pf[rr * 136 + j] - mx);
    Pf[rr * 136 + j] = e;
    ls += e;
  }
  for (int o = 8; o >= 1; o >>= 1) ls += __shfl_xor(ls, o);
  float inv = 1.f / (ls + __expf(sink - mx));
  __syncthreads();
  float o4[4] = {0.f, 0.f, 0.f, 0.f};
  for (int j = 0; j < 136; ++j) {
    float pj = Pf[rr * 136 + j];
    float4 v = *(const float4*)(Vf + j * 64 + tt * 4);
    o4[0] += pj * v.x; o4[1] += pj * v.y; o4[2] += pj * v.z; o4[3] += pj * v.w;
  }
  long tok = (long)NP + b * 8 + s;
  uint2 o;
  o.x = pack2(o4[0] * inv, o4[1] * inv);
  o.y = pack2(o4[2] * inv, o4[3] * inv);
  *(uint2*)(ao + tok * 512 + (kvh * 4 + hl) * 64 + tt * 4) = o;
}

__device__ __forceinline__ void phase_ln1(const int tix, const Params& p) {
  const int wid = tix >> 6, lane = tix & 63;
  const u16* rx = (const u16*)(p.ws + OFF_RX);
  u16* x1b = (u16*)(p.ws + OFF_X1B);
  for (int row = blockIdx.x * 8 + wid; row < NT; row += gridDim.x * 8) {
    float4 v[4];
    float s = 0.f;
#pragma unroll
    for (int i = 0; i < 4; ++i) {
      const uint2 w_ = *(const uint2*)(rx + (long)row * 1024 + i * 256 + lane * 4);
      v[i] = make_float4(__uint_as_float(w_.x << 16), __uint_as_float(w_.x & 0xffff0000u), __uint_as_float(w_.y << 16), __uint_as_float(w_.y & 0xffff0000u));
      s += v[i].x + v[i].y + v[i].z + v[i].w;
    }
    float mu = wave_sum(s) * (1.f / 1024.f);
    float q = 0.f;
#pragma unroll
    for (int i = 0; i < 4; ++i) {
      float a = v[i].x - mu, b = v[i].y - mu, c = v[i].z - mu, d = v[i].w - mu;
      q += a * a + b * b + c * c + d * d;
    }
    float rstd = rsqrtf(wave_sum(q) * (1.f / 1024.f) + 1e-5f);
#pragma unroll
    for (int i = 0; i < 4; ++i) {
      int c = i * 256 + lane * 4;
      float4 g = *(const float4*)(p.ln1_g + c), bb = *(const float4*)(p.ln1_b + c);
      float4 o;
      o.x = (v[i].x - mu) * rstd * g.x + bb.x;
      o.y = (v[i].y - mu) * rstd * g.y + bb.y;
      o.z = (v[i].z - mu) * rstd * g.z + bb.z;
      o.w = (v[i].w - mu) * rstd * g.w + bb.w;
      uint2 ob;
      ob.x = pack2(o.x, o.y);
      ob.y = pack2(o.z, o.w);
      *(uint2*)(x1b + (long)row * 1024 + c) = ob;
    }
  }
}

__device__ __forceinline__ void phase_conv(const int tix, const Params& p, const int wk, const int nwk, const int part) {
  const long T = (long)nwk * 512;
  const long tid = (long)wk * 512 + tix;
  uint4* pu = (uint4*)(p.ws + OFF_PU);
  uint4* pv = (uint4*)(p.ws + OFF_PV);
  for (long i = (long)part * (8192L * 64) + tid; i < (long)(part + 1) * (8192L * 64); i += T) {
    uint4 oa, ob;
    unsigned* wa = (unsigned*)&oa;
    unsigned* wb = (unsigned*)&ob;
#pragma unroll
    for (int q = 0; q < 4; ++q) {
      float4 a = ldnt4((const float*)(p.peer_u + i * 16 + q * 4));
      float4 b = ldnt4((const float*)(p.peer_v + i * 16 + q * 4));
      int w = 0;
      w = __builtin_amdgcn_cvt_pk_fp8_f32(a.x * PU_SCALE, a.y * PU_SCALE, w, false);
      w = __builtin_amdgcn_cvt_pk_fp8_f32(a.z * PU_SCALE, a.w * PU_SCALE, w, true);
      wa[q] = (unsigned)w;
      w = 0;
      w = __builtin_amdgcn_cvt_pk_fp8_f32(b.x * PV_SCALE, b.y * PV_SCALE, w, false);
      w = __builtin_amdgcn_cvt_pk_fp8_f32(b.z * PV_SCALE, b.w * PV_SCALE, w, true);
      wb[q] = (unsigned)w;
    }
    pu[i] = oa;
    pv[i] = ob;
  }
}

__device__ __forceinline__ void sort16_desc(unsigned (&s)[16]) {
  { unsigned hi_ = max(s[0], s[1]), lo_ = min(s[0], s[1]); s[0] = hi_; s[1] = lo_; }
  { unsigned hi_ = max(s[2], s[3]), lo_ = min(s[2], s[3]); s[2] = lo_; s[3] = hi_; }
  { unsigned hi_ = max(s[4], s[5]), lo_ = min(s[4], s[5]); s[4] = hi_; s[5] = lo_; }
  { unsigned hi_ = max(s[6], s[7]), lo_ = min(s[6], s[7]); s[6] = lo_; s[7] = hi_; }
  { unsigned hi_ = max(s[8], s[9]), lo_ = min(s[8], s[9]); s[8] = hi_; s[9] = lo_; }
  { unsigned hi_ = max(s[10], s[11]), lo_ = min(s[10], s[11]); s[10] = lo_; s[11] = hi_; }
  { unsigned hi_ = max(s[12], s[13]), lo_ = min(s[12], s[13]); s[12] = hi_; s[13] = lo_; }
  { unsigned hi_ = max(s[14], s[15]), lo_ = min(s[14], s[15]); s[14] = lo_; s[15] = hi_; }
  { unsigned hi_ = max(s[0], s[2]), lo_ = min(s[0], s[2]); s[0] = hi_; s[2] = lo_; }
  { unsigned hi_ = max(s[1], s[3]), lo_ = min(s[1], s[3]); s[1] = hi_; s[3] = lo_; }
  { unsigned hi_ = max(s[4], s[6]), lo_ = min(s[4], s[6]); s[4] = lo_; s[6] = hi_; }
  { unsigned hi_ = max(s[5], s[7]), lo_ = min(s[5], s[7]); s[5] = lo_; s[7] = hi_; }
  { unsigned hi_ = max(s[8], s[10]), lo_ = min(s[8], s[10]); s[8] = hi_; s[10] = lo_; }
  { unsigned hi_ = max(s[9], s[11]), lo_ = min(s[9], s[11]); s[9] = hi_; s[11] = lo_; }
  { unsigned hi_ = max(s[12], s[14]), lo_ = min(s[12], s[14]); s[12] = lo_; s[14] = hi_; }
  { unsigned hi_ = max(s[13], s[15]), lo_ = min(s[13], s[15]); s[13] = lo_; s[15] = hi_; }
  { unsigned hi_ = max(s[0], s[1]), lo_ = min(s[0], s[1]); s[0] = hi_; s[1] = lo_; }
  { unsigned hi_ = max(s[2], s[3]), lo_ = min(s[2], s[3]); s[2] = hi_; s[3] = lo_; }
  { unsigned hi_ = max(s[4], s[5]), lo_ = min(s[4], s[5]); s[4] = lo_; s[5] = hi_; }
  { unsigned hi_ = max(s[6], s[7]), lo_ = min(s[6], s[7]); s[6] = lo_; s[7] = hi_; }
  { unsigned hi_ = max(s[8], s[9]), lo_ = min(s[8], s[9]); s[8] = hi_; s[9] = lo_; }
  { unsigned hi_ = max(s[10], s[11]), lo_ = min(s[10], s[11]); s[10] = hi_; s[11] = lo_; }
  { unsigned hi_ = max(s[12], s[13]), lo_ = min(s[12], s[13]); s[12] = lo_; s[13] = hi_; }
  { unsigned hi_ = max(s[14], s[15]), lo_ = min(s[14], s[15]); s[14] = lo_; s[15] = hi_; }
  { unsigned hi_ = max(s[0], s[4]), lo_ = min(s[0], s[4]); s[0] = hi_; s[4] = lo_; }
  { unsigned hi_ = max(s[1], s[5]), lo_ = min(s[1], s[5]); s[1] = hi_; s[5] = lo_; }
  { unsigned hi_ = max(s[2], s[6]), lo_ = min(s[2], s[6]); s[2] = hi_; s[6] = lo_; }
  { unsigned hi_ = max(s[3], s[7]), lo_ = min(s[3], s[7]); s[3] = hi_; s[7] = lo_; }
  { unsigned hi_ = max(s[8], s[12]), lo_ = min(s[8], s[12]); s[8] = lo_; s[12] = hi_; }
  { unsigned hi_ = max(s[9], s[13]), lo_ = min(s[9], s[13]); s[9] = lo_; s[13] = hi_; }
  { unsigned hi_ = max(s[10], s[14]), lo_ = min(s[10], s[14]); s[10] = lo_; s[14] = hi_; }
  { unsigned hi_ = max(s[11], s[15]), lo_ = min(s[11], s[15]); s[11] = lo_; s[15] = hi_; }
  { unsigned hi_ = max(s[0], s[2]), lo_ = min(s[0], s[2]); s[0] = hi_; s[2] = lo_; }
  { unsigned hi_ = max(s[1], s[3]), lo_ = min(s[1], s[3]); s[1] = hi_; s[3] = lo_; }
  { unsigned hi_ = max(s[4], s[6]), lo_ = min(s[4], s[6]); s[4] = hi_; s[6] = lo_; }
  { unsigned hi_ = max(s[5], s[7]), lo_ = min(s[5], s[7]); s[5] = hi_; s[7] = lo_; }
  { unsigned hi_ = max(s[8], s[10]), lo_ = min(s[8], s[10]); s[8] = lo_; s[10] = hi_; }
  { unsigned hi_ = max(s[9], s[11]), lo_ = min(s[9], s[11]); s[9] = lo_; s[11] = hi_; }
  { unsigned hi_ = max(s[12], s[14]), lo_ = min(s[12], s[14]); s[12] = lo_; s[14] = hi_; }
  { unsigned hi_ = max(s[13], s[15]), lo_ = min(s[13], s[15]); s[13] = lo_; s[15] = hi_; }
  { unsigned hi_ = max(s[0], s[1]), lo_ = min(s[0], s[1]); s[0] = hi_; s[1] = lo_; }
  { unsigned hi_ = max(s[2], s[3]), lo_ = min(s[2], s[3]); s[2] = hi_; s[3] = lo_; }
  { unsigned hi_ = max(s[4], s[5]), lo_ = min(s[4], s[5]); s[4] = hi_; s[5] = lo_; }
  { unsigned hi_ = max(s[6], s[7]), lo_ = min(s[6], s[7]); s[6] = hi_; s[7] = lo_; }
  { unsigned hi_ = max(s[8], s[9]), lo_ = min(s[8], s[9]); s[8] = lo_; s[9] = hi_; }
  { unsigned hi_ = max(s[10], s[11]), lo_ = min(s[10], s[11]); s[10] = lo_; s[11] = hi_; }
  { unsigned hi_ = max(s[12], s[13]), lo_ = min(s[12], s[13]); s[12] = lo_; s[13] = hi_; }
  { unsigned hi_ = max(s[14], s[15]), lo_ = min(s[14], s[15]); s[14] = lo_; s[15] = hi_; }
  { unsigned hi_ = max(s[0], s[8]), lo_ = min(s[0], s[8]); s[0] = hi_; s[8] = lo_; }
  { unsigned hi_ = max(s[1], s[9]), lo_ = min(s[1], s[9]); s[1] = hi_; s[9] = lo_; }
  { unsigned hi_ = max(s[2], s[10]), lo_ = min(s[2], s[10]); s[2] = hi_; s[10] = lo_; }
  { unsigned hi_ = max(s[3], s[11]), lo_ = min(s[3], s[11]); s[3] = hi_; s[11] = lo_; }
  { unsigned hi_ = max(s[4], s[12]), lo_ = min(s[4], s[12]); s[4] = hi_; s[12] = lo_; }
  { unsigned hi_ = max(s[5], s[13]), lo_ = min(s[5], s[13]); s[5] = hi_; s[13] = lo_; }
  { unsigned hi_ = max(s[6], s[14]), lo_ = min(s[6], s[14]); s[6] = hi_; s[14] = lo_; }
  { unsigned hi_ = max(s[7], s[15]), lo_ = min(s[7], s[15]); s[7] = hi_; s[15] = lo_; }
  { unsigned hi_ = max(s[0], s[4]), lo_ = min(s[0], s[4]); s[0] = hi_; s[4] = lo_; }
  { unsigned hi_ = max(s[1], s[5]), lo_ = min(s[1], s[5]); s[1] = hi_; s[5] = lo_; }
  { unsigned hi_ = max(s[2], s[6]), lo_ = min(s[2], s[6]); s[2] = hi_; s[6] = lo_; }
  { unsigned hi_ = max(s[3], s[7]), lo_ = min(s[3], s[7]); s[3] = hi_; s[7] = lo_; }
  { unsigned hi_ = max(s[8], s[12]), lo_ = min(s[8], s[12]); s[8] = hi_; s[12] = lo_; }
  { unsigned hi_ = max(s[9], s[13]), lo_ = min(s[9], s[13]); s[9] = hi_; s[13] = lo_; }
  { unsigned hi_ = max(s[10], s[14]), lo_ = min(s[10], s[14]); s[10] = hi_; s[14] = lo_; }
  { unsigned hi_ = max(s[11], s[15]), lo_ = min(s[11], s[15]); s[11] = hi_; s[15] = lo_; }
  { unsigned hi_ = max(s[0], s[2]), lo_ = min(s[0], s[2]); s[0] = hi_; s[2] = lo_; }
  { unsigned hi_ = max(s[1], s[3]), lo_ = min(s[1], s[3]); s[1] = hi_; s[3] = lo_; }
  { unsigned hi_ = max(s[4], s[6]), lo_ = min(s[4], s[6]); s[4] = hi_; s[6] = lo_; }
  { unsigned hi_ = max(s[5], s[7]), lo_ = min(s[5], s[7]); s[5] = hi_; s[7] = lo_; }
  { unsigned hi_ = max(s[8], s[10]), lo_ = min(s[8], s[10]); s[8] = hi_; s[10] = lo_; }
  { unsigned hi_ = max(s[9], s[11]), lo_ = min(s[9], s[11]); s[9] = hi_; s[11] = lo_; }
  { unsigned hi_ = max(s[12], s[14]), lo_ = min(s[12], s[14]); s[12] = hi_; s[14] = lo_; }
  { unsigned hi_ = max(s[13], s[15]), lo_ = min(s[13], s[15]); s[13] = hi_; s[15] = lo_; }
  { unsigned hi_ = max(s[0], s[1]), lo_ = min(s[0], s[1]); s[0] = hi_; s[1] = lo_; }
  { unsigned hi_ = max(s[2], s[3]), lo_ = min(s[2], s[3]); s[2] = hi_; s[3] = lo_; }
  { unsigned hi_ = max(s[4], s[5]), lo_ = min(s[4], s[5]); s[4] = hi_; s[5] = lo_; }
  { unsigned hi_ = max(s[6], s[7]), lo_ = min(s[6], s[7]); s[6] = hi_; s[7] = lo_; }
  { unsigned hi_ = max(s[8], s[9]), lo_ = min(s[8], s[9]); s[8] = hi_; s[9] = lo_; }
  { unsigned hi_ = max(s[10], s[11]), lo_ = min(s[10], s[11]); s[10] = hi_; s[11] = lo_; }
  { unsigned hi_ = max(s[12], s[13]), lo_ = min(s[12], s[13]); s[12] = hi_; s[13] = lo_; }
  { unsigned hi_ = max(s[14], s[15]), lo_ = min(s[14], s[15]); s[14] = hi_; s[15] = lo_; }
}
__device__ __forceinline__ void merge16_desc(unsigned (&t)[16], const unsigned (&s)[16]) {
#pragma unroll
  for (int i = 0; i < 16; ++i) t[i] = max(t[i], s[15 - i]);
  { unsigned hi_ = max(t[0], t[8]), lo_ = min(t[0], t[8]); t[0] = hi_; t[8] = lo_; }
  { unsigned hi_ = max(t[1], t[9]), lo_ = min(t[1], t[9]); t[1] = hi_; t[9] = lo_; }
  { unsigned hi_ = max(t[2], t[10]), lo_ = min(t[2], t[10]); t[2] = hi_; t[10] = lo_; }
  { unsigned hi_ = max(t[3], t[11]), lo_ = min(t[3], t[11]); t[3] = hi_; t[11] = lo_; }
  { unsigned hi_ = max(t[4], t[12]), lo_ = min(t[4], t[12]); t[4] = hi_; t[12] = lo_; }
  { unsigned hi_ = max(t[5], t[13]), lo_ = min(t[5], t[13]); t[5] = hi_; t[13] = lo_; }
  { unsigned hi_ = max(t[6], t[14]), lo_ = min(t[6], t[14]); t[6] = hi_; t[14] = lo_; }
  { unsigned hi_ = max(t[7], t[15]), lo_ = min(t[7], t[15]); t[7] = hi_; t[15] = lo_; }
  { unsigned hi_ = max(t[0], t[4]), lo_ = min(t[0], t[4]); t[0] = hi_; t[4] = lo_; }
  { unsigned hi_ = max(t[1], t[5]), lo_ = min(t[1], t[5]); t[1] = hi_; t[5] = lo_; }
  { unsigned hi_ = max(t[2], t[6]), lo_ = min(t[2], t[6]); t[2] = hi_; t[6] = lo_; }
  { unsigned hi_ = max(t[3], t[7]), lo_ = min(t[3], t[7]); t[3] = hi_; t[7] = lo_; }
  { unsigned hi_ = max(t[8], t[12]), lo_ = min(t[8], t[12]); t[8] = hi_; t[12] = lo_; }
  { unsigned hi_ = max(t[9], t[13]), lo_ = min(t[9], t[13]); t[9] = hi_; t[13] = lo_; }
  { unsigned hi_ = max(t[10], t[14]), lo_ = min(t[10], t[14]); t[10] = hi_; t[14] = lo_; }
  { unsigned hi_ = max(t[11], t[15]), lo_ = min(t[11], t[15]); t[11] = hi_; t[15] = lo_; }
  { unsigned hi_ = max(t[0], t[2]), lo_ = min(t[0], t[2]); t[0] = hi_; t[2] = lo_; }
  { unsigned hi_ = max(t[1], t[3]), lo_ = min(t[1], t[3]); t[1] = hi_; t[3] = lo_; }
  { unsigned hi_ = max(t[4], t[6]), lo_ = min(t[4], t[6]); t[4] = hi_; t[6] = lo_; }
  { unsigned hi_ = max(t[5], t[7]), lo_ = min(t[5], t[7]); t[5] = hi_; t[7] = lo_; }
  { unsigned hi_ = max(t[8], t[10]), lo_ = min(t[8], t[10]); t[8] = hi_; t[10] = lo_; }
  { unsigned hi_ = max(t[9], t[11]), lo_ = min(t[9], t[11]); t[9] = hi_; t[11] = lo_; }
  { unsigned hi_ = max(t[12], t[14]), lo_ = min(t[12], t[14]); t[12] = hi_; t[14] = lo_; }
  { unsigned hi_ = max(t[13], t[15]), lo_ = min(t[13], t[15]); t[13] = hi_; t[15] = lo_; }
  { unsigned hi_ = max(t[0], t[1]), lo_ = min(t[0], t[1]); t[0] = hi_; t[1] = lo_; }
  { unsigned hi_ = max(t[2], t[3]), lo_ = min(t[2], t[3]); t[2] = hi_; t[3] = lo_; }
  { unsigned hi_ = max(t[4], t[5]), lo_ = min(t[4], t[5]); t[4] = hi_; t[5] = lo_; }
  { unsigned hi_ = max(t[6], t[7]), lo_ = min(t[6], t[7]); t[6] = hi_; t[7] = lo_; }
  { unsigned hi_ = max(t[8], t[9]), lo_ = min(t[8], t[9]); t[8] = hi_; t[9] = lo_; }
  { unsigned hi_ = max(t[10], t[11]), lo_ = min(t[10], t[11]); t[10] = hi_; t[11] = lo_; }
  { unsigned hi_ = max(t[12], t[13]), lo_ = min(t[12], t[13]); t[12] = hi_; t[13] = lo_; }
  { unsigned hi_ = max(t[14], t[15]), lo_ = min(t[14], t[15]); t[14] = hi_; t[15] = lo_; }
}
__device__ __forceinline__ void topk_insert(const unsigned short* sc, unsigned* t_out) {
  unsigned t[16], s[16];
  uint4 c0 = *(const uint4*)sc, c1 = *(const uint4*)(sc + 8), n0 = c0, n1 = c1;
#pragma unroll 1
  for (int c = 0; c < 8; ++c) {
    if (c + 1 < 8) { n0 = *(const uint4*)(sc + (c + 1) * 16); n1 = *(const uint4*)(sc + (c + 1) * 16 + 8); }
    const unsigned w[8] = {c0.x, c0.y, c0.z, c0.w, c1.x, c1.y, c1.z, c1.w};
#pragma unroll
    for (int e = 0; e < 16; ++e) {
      const unsigned ww = w[e >> 1];
      const unsigned h = (e & 1) ? (ww >> 16) : (ww & 0xffffu);
      const int m = (e & 1) ? ((int)ww >> 31) : ((int)(ww << 16) >> 31);
      const unsigned key = h ^ (0x8000u | ((unsigned)m & 0x7fffu));
      s[e] = (key << 16) | (unsigned)(127 - (c * 16 + e));
    }
    sort16_desc(s);
    if (c == 0) {
#pragma unroll
      for (int i = 0; i < 16; ++i) t[i] = s[i];
    } else {
      merge16_desc(t, s);
    }
    c0 = n0; c1 = n1;
  }
#pragma unroll
  for (int i = 0; i < 16; ++i) t_out[i] = t[i];
}
__device__ __forceinline__ float key_to_f32(unsigned t) {
  unsigned key = t >> 16;
  unsigned h = (key & 0x8000u) ? (key ^ 0x8000u) : (key ^ 0xffffu);
  return (float)__builtin_bit_cast(_Float16, (unsigned short)h);
}

template <int LV>
__device__ __forceinline__ void cand_insert(float vc, float (&tv)[16]) {
#pragma unroll
  for (int k = 0; k < LV; ++k) {
    const float hi = fmaxf(tv[k], vc);
    vc = fminf(tv[k], vc);
    tv[k] = hi;
  }
}

__device__ __forceinline__ void phase_peer(const int tix, const Params& p, unsigned char* smem) {
  const int wid = tix >> 6, lane = tix & 63;
  int* sidx_all = (int*)smem;
  float* sgate_all = (float*)(smem + 34816);
  int* cnt = (int*)(smem + 69632);
  float* sh_all = (float*)(smem + 69632 + 64);
  const unsigned short* SC = (const unsigned short*)(p.ws + OFF_SC);
  const u16* X1B = (const u16*)(p.ws + OFF_X1B);
  const unsigned char* PU = (const unsigned char*)(p.ws + OFF_PU);
  const unsigned char* PV = (const unsigned char*)(p.ws + OFF_PV);
  for (int blk = blockIdx.x; blk < 256; blk += gridDim.x) {
   const int tok0 = blk * 68;
   __syncthreads();
   if (tix == 0) { cnt[0] = 64; cnt[1] = 0; }
   __syncthreads();
#pragma unroll 1
   for (int pass = (wid == 0 ? 0 : 1); pass < 2; ++pass) {
    const int rowbase = pass == 0 ? 512 : wid * 64;
    const int row = rowbase + lane;
    const bool act = row < 544;
    const int rr = act ? row : 0, tl = rr >> 3, hh = rr & 7;
    const unsigned short* sc = SC + (long)(tok0 + tl) * 2048 + hh * 256;
    unsigned t1[16], t2[16];
    topk_insert(sc, t1);
    topk_insert(sc + 128, t2);
    float f1[16], f2[16];
#pragma unroll
    for (int k = 0; k < 16; ++k) { f1[k] = key_to_f32(t1[k]); f2[k] = key_to_f32(t2[k]); }
    int id1[16], id2[16];
#pragma unroll
    for (int k = 0; k < 16; ++k) { id1[k] = (127 - (int)(t1[k] & 0x7fu)) * 128; id2[k] = 127 - (int)(t2[k] & 0x7fu); }
    float tv[16];
#pragma unroll
    for (int k = 0; k < 16; ++k) tv[k] = -INFINITY;
    cand_insert<1>(f1[0] + f2[0], tv);
    cand_insert<2>(f1[0] + f2[1], tv);
    cand_insert<3>(f1[0] + f2[2], tv);
    cand_insert<4>(f1[0] + f2[3], tv);
    cand_insert<5>(f1[0] + f2[4], tv);
    cand_insert<6>(f1[0] + f2[5], tv);
    cand_insert<7>(f1[0] + f2[6], tv);
    cand_insert<8>(f1[0] + f2[7], tv);
    cand_insert<9>(f1[0] + f2[8], tv);
    cand_insert<10>(f1[0] + f2[9], tv);
    cand_insert<11>(f1[0] + f2[10], tv);
    cand_insert<12>(f1[0] + f2[11], tv);
    cand_insert<13>(f1[0] + f2[12], tv);
    cand_insert<14>(f1[0] + f2[13], tv);
    cand_insert<15>(f1[0] + f2[14], tv);
    cand_insert<16>(f1[0] + f2[15], tv);
    cand_insert<16>(f1[1] + f2[0], tv);
    cand_insert<16>(f1[1] + f2[1], tv);
    cand_insert<16>(f1[1] + f2[2], tv);
    cand_insert<16>(f1[1] + f2[3], tv);
    cand_insert<16>(f1[1] + f2[4], tv);
    cand_insert<16>(f1[1] + f2[5], tv);
    cand_insert<16>(f1[1] + f2[6], tv);
    cand_insert<16>(f1[1] + f2[7], tv);
    cand_insert<16>(f1[2] + f2[0], tv);
    cand_insert<16>(f1[2] + f2[1], tv);
    cand_insert<16>(f1[2] + f2[2], tv);
    cand_insert<16>(f1[2] + f2[3], tv);
    cand_insert<16>(f1[2] + f2[4], tv);
    cand_insert<16>(f1[3] + f2[0], tv);
    cand_insert<16>(f1[3] + f2[1], tv);
    cand_insert<16>(f1[3] + f2[2], tv);
    cand_insert<16>(f1[3] + f2[3], tv);
    cand_insert<16>(f1[4] + f2[0], tv);
    cand_insert<16>(f1[4] + f2[1], tv);
    cand_insert<16>(f1[4] + f2[2], tv);
    cand_insert<16>(f1[5] + f2[0], tv);
    cand_insert<16>(f1[5] + f2[1], tv);
    cand_insert<16>(f1[6] + f2[0], tv);
    cand_insert<16>(f1[6] + f2[1], tv);
    cand_insert<16>(f1[7] + f2[0], tv);
    cand_insert<16>(f1[7] + f2[1], tv);
    cand_insert<16>(f1[8] + f2[0], tv);
    cand_insert<16>(f1[9] + f2[0], tv);
    cand_insert<16>(f1[10] + f2[0], tv);
    cand_insert<16>(f1[11] + f2[0], tv);
    cand_insert<16>(f1[12] + f2[0], tv);
    cand_insert<16>(f1[13] + f2[0], tv);
    cand_insert<16>(f1[14] + f2[0], tv);
    cand_insert<16>(f1[15] + f2[0], tv);
    float den = 0.f;
#pragma unroll
    for (int k = 0; k < 16; ++k) den += __expf(tv[k] - tv[0]);
    const float inv = 1.f / den, T = tv[15], top = tv[0];
    int ngt = 0;
    ngt += (f1[0] + f2[0] > T) ? 1 : 0;
    ngt += (f1[0] + f2[1] > T) ? 1 : 0;
    ngt += (f1[0] + f2[2] > T) ? 1 : 0;
    ngt += (f1[0] + f2[3] > T) ? 1 : 0;
    ngt += (f1[0] + f2[4] > T) ? 1 : 0;
    ngt += (f1[0] + f2[5] > T) ? 1 : 0;
    ngt += (f1[0] + f2[6] > T) ? 1 : 0;
    ngt += (f1[0] + f2[7] > T) ? 1 : 0;
    ngt += (f1[0] + f2[8] > T) ? 1 : 0;
    ngt += (f1[0] + f2[9] > T) ? 1 : 0;
    ngt += (f1[0] + f2[10] > T) ? 1 : 0;
    ngt += (f1[0] + f2[11] > T) ? 1 : 0;
    ngt += (f1[0] + f2[12] > T) ? 1 : 0;
    ngt += (f1[0] + f2[13] > T) ? 1 : 0;
    ngt += (f1[0] + f2[14] > T) ? 1 : 0;
    ngt += (f1[0] + f2[15] > T) ? 1 : 0;
    ngt += (f1[1] + f2[0] > T) ? 1 : 0;
    ngt += (f1[1] + f2[1] > T) ? 1 : 0;
    ngt += (f1[1] + f2[2] > T) ? 1 : 0;
    ngt += (f1[1] + f2[3] > T) ? 1 : 0;
    ngt += (f1[1] + f2[4] > T) ? 1 : 0;
    ngt += (f1[1] + f2[5] > T) ? 1 : 0;
    ngt += (f1[1] + f2[6] > T) ? 1 : 0;
    ngt += (f1[1] + f2[7] > T) ? 1 : 0;
    ngt += (f1[2] + f2[0] > T) ? 1 : 0;
    ngt += (f1[2] + f2[1] > T) ? 1 : 0;
    ngt += (f1[2] + f2[2] > T) ? 1 : 0;
    ngt += (f1[2] + f2[3] > T) ? 1 : 0;
    ngt += (f1[2] + f2[4] > T) ? 1 : 0;
    ngt += (f1[3] + f2[0] > T) ? 1 : 0;
    ngt += (f1[3] + f2[1] > T) ? 1 : 0;
    ngt += (f1[3] + f2[2] > T) ? 1 : 0;
    ngt += (f1[3] + f2[3] > T) ? 1 : 0;
    ngt += (f1[4] + f2[0] > T) ? 1 : 0;
    ngt += (f1[4] + f2[1] > T) ? 1 : 0;
    ngt += (f1[4] + f2[2] > T) ? 1 : 0;
    ngt += (f1[5] + f2[0] > T) ? 1 : 0;
    ngt += (f1[5] + f2[1] > T) ? 1 : 0;
    ngt += (f1[6] + f2[0] > T) ? 1 : 0;
    ngt += (f1[6] + f2[1] > T) ? 1 : 0;
    ngt += (f1[7] + f2[0] > T) ? 1 : 0;
    ngt += (f1[7] + f2[1] > T) ? 1 : 0;
    ngt += (f1[8] + f2[0] > T) ? 1 : 0;
    ngt += (f1[9] + f2[0] > T) ? 1 : 0;
    ngt += (f1[10] + f2[0] > T) ? 1 : 0;
    ngt += (f1[11] + f2[0] > T) ? 1 : 0;
    ngt += (f1[12] + f2[0] > T) ? 1 : 0;
    ngt += (f1[13] + f2[0] > T) ? 1 : 0;
    ngt += (f1[14] + f2[0] > T) ? 1 : 0;
    ngt += (f1[15] + f2[0] > T) ? 1 : 0;
    int need = 16 - ngt, pos = 0;
    int* so = sidx_all + tl * 128 + hh * 16;
    float* go = sgate_all + tl * 128 + hh * 16;
#define CAND_EMIT(I, J)                                                        \
    {                                                                          \
      const float vc = f1[I] + f2[J];                                          \
      const bool eq = (vc == T) && (need > 0);                                 \
      const bool sel = (vc > T) || eq;                                         \
      need -= eq ? 1 : 0;                                                      \
      if (sel && act) { so[pos] = id1[I] + id2[J]; go[pos] = __expf(vc - top) * inv; } \
      pos += sel ? 1 : 0;                                                      \
    }
    CAND_EMIT(0, 0)
    CAND_EMIT(0, 1)
    CAND_EMIT(0, 2)
    CAND_EMIT(0, 3)
    CAND_EMIT(0, 4)
    CAND_EMIT(0, 5)
    CAND_EMIT(0, 6)
    CAND_EMIT(0, 7)
    CAND_EMIT(0, 8)
    CAND_EMIT(0, 9)
    CAND_EMIT(0, 10)
    CAND_EMIT(0, 11)
    CAND_EMIT(0, 12)
    CAND_EMIT(0, 13)
    CAND_EMIT(0, 14)
    CAND_EMIT(0, 15)
    CAND_EMIT(1, 0)
    CAND_EMIT(1, 1)
    CAND_EMIT(1, 2)
    CAND_EMIT(1, 3)
    CAND_EMIT(1, 4)
    CAND_EMIT(1, 5)
    CAND_EMIT(1, 6)
    CAND_EMIT(1, 7)
    CAND_EMIT(2, 0)
    CAND_EMIT(2, 1)
    CAND_EMIT(2, 2)
    CAND_EMIT(2, 3)
    CAND_EMIT(2, 4)
    CAND_EMIT(3, 0)
    CAND_EMIT(3, 1)
    CAND_EMIT(3, 2)
    CAND_EMIT(3, 3)
    CAND_EMIT(4, 0)
    CAND_EMIT(4, 1)
    CAND_EMIT(4, 2)
    CAND_EMIT(5, 0)
    CAND_EMIT(5, 1)
    CAND_EMIT(6, 0)
    CAND_EMIT(6, 1)
    CAND_EMIT(7, 0)
    CAND_EMIT(7, 1)
    CAND_EMIT(8, 0)
    CAND_EMIT(9, 0)
    CAND_EMIT(10, 0)
    CAND_EMIT(11, 0)
    CAND_EMIT(12, 0)
    CAND_EMIT(13, 0)
    CAND_EMIT(14, 0)
    CAND_EMIT(15, 0)
#undef CAND_EMIT
    if (pass == 0) {
      asm volatile("s_waitcnt lgkmcnt(0)" ::: "memory");
      if (lane == 0) __hip_atomic_store(&cnt[1], 1, __ATOMIC_RELAXED, __HIP_MEMORY_SCOPE_WORKGROUP);
    }
   }
#pragma unroll 1
   for (int it = 0;; ++it) {
    int tl = wid * 8 + (it & 7);
    int mode = it < 16 ? 1 : 2;
    int cp_lo = it >> 3, cp_hi = it >> 3;
    if (it >= 24) {
      mode = 3; cp_lo = 0; cp_hi = 1;
      tl = 0;
      if (lane == 0) tl = atomicAdd(cnt, 1);
      tl = __builtin_amdgcn_readfirstlane(tl);
      if (tl >= 68) break;
      while (__hip_atomic_load(&cnt[1], __ATOMIC_RELAXED, __HIP_MEMORY_SCOPE_WORKGROUP) == 0) __builtin_amdgcn_s_sleep(1);
    }
    const int tok = tok0 + tl;
    int* sidx = sidx_all + tl * 128;
    float* sgate = sgate_all + tl * 128;
    f32x2 x2[8];
    {
      const uint4* xb_ = (const uint4*)(X1B + (long)tok * 1024 + lane * 16);
      uint4 w0 = xb_[0], w1 = xb_[1];
      unsigned w[8] = {w0.x, w0.y, w0.z, w0.w, w1.x, w1.y, w1.z, w1.w};
#pragma unroll
      for (int i = 0; i < 8; ++i) x2[i] = (f32x2){__uint_as_float(w[i] << 16), __uint_as_float(w[i] & 0xffff0000u)};
    }
    float hv0 = 0.f, hv1 = 0.f;
    uint4 ba[8], bb[8];
#define PLOAD(BUF, TAB, e0)                                                                   \
  _Pragma("unroll") for (int u = 0; u < 8; ++u)                                              \
      BUF[u] = *(const uint4*)(TAB + (long)sidx[(e0) + u] * 1024 + lane * 16);
#define PDOT(BUF, e0)                                                                         \
  _Pragma("unroll") for (int u = 0; u < 8; ++u) {                                            \
    unsigned w[4] = {BUF[u].x, BUF[u].y, BUF[u].z, BUF[u].w};                                 \
    f32x2 s2 = {0.f, 0.f};                                                                    \
    _Pragma("unroll") for (int kk = 0; kk < 4; ++kk) {                                        \
      f32x2 lo = __builtin_amdgcn_cvt_pk_f32_fp8((int)w[kk], false);                          \
      f32x2 hi = __builtin_amdgcn_cvt_pk_f32_fp8((int)w[kk], true);                           \
      s2 += lo * x2[kk * 2];                                                                  \
      s2 += hi * x2[kk * 2 + 1];                                                              \
    }                                                                                         \
    float tot = wsum(s2[0] + s2[1]);                                                          \
    int ee = (e0) + u;                                                                        \
    if (lane == (ee & 63)) { if (ee < 64) hv0 = tot; else hv1 = tot; }                        \
  }
#define PAXPY(BUF, e0)                                                                        \
  _Pragma("unroll") for (int u = 0; u < 8; ++u) {                                            \
    float a = sgate[(e0) + u];                                                                \
    f32x2 a2 = {a, a};                                                                        \
    unsigned w[4] = {BUF[u].x, BUF[u].y, BUF[u].z, BUF[u].w};                                 \
    _Pragma("unroll") for (int kk = 0; kk < 4; ++kk) {                                        \
      f32x2 lo = __builtin_amdgcn_cvt_pk_f32_fp8((int)w[kk], false);                          \
      f32x2 hi = __builtin_amdgcn_cvt_pk_f32_fp8((int)w[kk], true);                           \
      o2[kk * 2] += a2 * lo;                                                                  \
      o2[kk * 2 + 1] += a2 * hi;                                                              \
    }                                                                                         \
  }
    if (mode & 1) {
      float* sh = sh_all + tl * 128;
#pragma unroll 1
      for (int cp = cp_lo; cp <= cp_hi; ++cp) {
        const int colb = cp * 512 + (lane & 31) * 16;
        f32x2 xh[8];
        {
          const uint4* xb_ = (const uint4*)(X1B + (long)tok * 1024 + colb);
          uint4 w0 = xb_[0], w1 = xb_[1];
          unsigned w[8] = {w0.x, w0.y, w0.z, w0.w, w1.x, w1.y, w1.z, w1.w};
#pragma unroll
          for (int i = 0; i < 8; ++i) xh[i] = (f32x2){__uint_as_float(w[i] << 16), __uint_as_float(w[i] & 0xffff0000u)};
        }
#define PLOADU(BUF, e0)                                                                       \
  _Pragma("unroll") for (int u = 0; u < 8; ++u)                                              \
      BUF[u] = *(const uint4*)(PU + (long)sidx[(e0) + 2 * u + (lane >> 5)] * 1024 + colb);
#define PDOTU(BUF, e0)                                                                        \
  _Pragma("unroll") for (int u = 0; u < 8; ++u) {                                            \
    unsigned w[4] = {BUF[u].x, BUF[u].y, BUF[u].z, BUF[u].w};                                 \
    f32x2 s2 = {0.f, 0.f};                                                                    \
    _Pragma("unroll") for (int kk = 0; kk < 4; ++kk) {                                        \
      f32x2 lo = __builtin_amdgcn_cvt_pk_f32_fp8((int)w[kk], false);                          \
      f32x2 hi = __builtin_amdgcn_cvt_pk_f32_fp8((int)w[kk], true);                           \
      s2 += lo * xh[kk * 2];                                                                  \
      s2 += hi * xh[kk * 2 + 1];                                                              \
    }                                                                                         \
    const float v_ = row_sum16(s2[0] + s2[1]);                                                \
    float ta_ = rlane(v_, 0) + rlane(v_, 16), tb_ = rlane(v_, 32) + rlane(v_, 48);            \
    if (lane == 0) {                                                                          \
      if (cp) { ta_ += sh[(e0) + 2 * u]; tb_ += sh[(e0) + 2 * u + 1]; }                       \
      sh[(e0) + 2 * u] = ta_; sh[(e0) + 2 * u + 1] = tb_;                                     \
    }                                                                                         \
  }
        PLOADU(ba, 0)
#pragma unroll 1
        for (int e = 0; e < 128; e += 32) {
          PLOADU(bb, e + 16)
          PDOTU(ba, e)
          if (e + 32 < 128) { PLOADU(ba, e + 32) }
          PDOTU(bb, e + 16)
        }
#undef PLOADU
#undef PDOTU
      }
      if (cp_hi == 1) {
        float g0 = sgate[lane], g1 = sgate[lane + 64];
        sgate[lane] = gelu_(sh[lane] * (1.f / PU_SCALE)) * g0 * (1.f / PV_SCALE);
        sgate[lane + 64] = gelu_(sh[lane + 64] * (1.f / PU_SCALE)) * g1 * (1.f / PV_SCALE);
      }
    }
    if (!(mode & 2)) continue;
    f32x2 o2[8];
#pragma unroll
    for (int i = 0; i < 8; ++i) o2[i] = (f32x2){0.f, 0.f};
    PLOAD(ba, PV, 0)
#pragma unroll 1
    for (int e = 0; e < 128; e += 16) {
      PLOAD(bb, PV, e + 8)
      PAXPY(ba, e)
      if (e + 16 < 128) { PLOAD(ba, PV, e + 16) }
      PAXPY(bb, e + 8)
    }
#undef PLOAD
#undef PDOT
#undef PAXPY
    float o[16];
    float s = 0.f;
#pragma unroll
    for (int i = 0; i < 8; ++i) {
      o[2 * i] = ALPHA * x2[i][0] + o2[i][0];
      o[2 * i + 1] = ALPHA * x2[i][1] + o2[i][1];
      s += o[2 * i] + o[2 * i + 1];
    }
    float mu = wsum(s) * (1.f / 1024.f);
    float q = 0.f;
#pragma unroll
    for (int i = 0; i < 16; ++i) { float dd = o[i] - mu; q += dd * dd; }
    float rstd = rsqrtf(wsum(q) * (1.f / 1024.f) + 1e-5f);
#pragma unroll
    for (int i = 0; i < 4; ++i) {
      int cc = lane * 16 + i * 4;
      float4 g = *(const float4*)(p.ln2_g + cc), bb = *(const float4*)(p.ln2_b + cc);
      float4 y;
      y.x = (o[i * 4] - mu) * rstd * g.x + bb.x;
      y.y = (o[i * 4 + 1] - mu) * rstd * g.y + bb.y;
      y.z = (o[i * 4 + 2] - mu) * rstd * g.z + bb.z;
      y.w = (o[i * 4 + 3] - mu) * rstd * g.w + bb.w;
      __builtin_nontemporal_store(y.x, p.out + O_Y + (long)tok * 1024 + cc);
      __builtin_nontemporal_store(y.y, p.out + O_Y + (long)tok * 1024 + cc + 1);
      __builtin_nontemporal_store(y.z, p.out + O_Y + (long)tok * 1024 + cc + 2);
      __builtin_nontemporal_store(y.w, p.out + O_Y + (long)tok * 1024 + cc + 3);
    }
   }
  }
}

__device__ __forceinline__ Params load_params() {
  Params r;
#if defined(__HIP_DEVICE_COMPILE__)
  typedef const __attribute__((address_space(4))) unsigned long long* KP;
  KP k = (KP)__builtin_amdgcn_kernarg_segment_ptr();
  asm volatile("" : "+s"(k));
  unsigned long long* d = (unsigned long long*)&r;
#pragma unroll
  for (int i = 0; i < (int)(sizeof(Params) / 8); ++i) d[i] = k[i];
#endif
  return r;
}

__device__ __forceinline__ int make_tid(int wave_s) {
  int l;
  asm volatile("v_mbcnt_lo_u32_b32 %0, -1, 0\n\tv_mbcnt_hi_u32_b32 %0, -1, %0" : "=v"(l));
  return wave_s * 64 + l;
}

__global__ void __launch_bounds__(512) mega(Params p_unused, int ph_lo, int ph_hi) {
  extern __shared__ __attribute__((aligned(16))) unsigned char smem[];
  cg::grid_group grid = cg::this_grid();
  __shared__ uint4 xb_words;
  volatile LAS unsigned* xb_st = (volatile LAS unsigned*)&xb_words;
  if (threadIdx.x == 0) {
    xb_words = make_uint4(0u, 0u, 0u, 0u);
    const Params p0 = load_params();
    (void)xb_add(&((unsigned*)(p0.ws + WS_END))[XB_XCNT(xb_xcc_id())], 1u);
  }
  __syncthreads();
  if (ph_hi > 1000) grid.sync();
  const int wave_s = __builtin_amdgcn_readfirstlane((int)threadIdx.x >> 6);

#define PHASE(k, ...)                                                                     \
  if (ph_lo <= (k) && (k) < ph_hi) {                                                      \
    const Params p = load_params();                                                       \
    const int tix = make_tid(wave_s);                                                     \
    unsigned char* ws = p.ws;                                                             \
    { __VA_ARGS__ }                                                                       \
    if ((k) == REP) { __syncthreads(); { __VA_ARGS__ } }                                  \
    if ((k) + 1 < ph_hi) { gbar(tix, (unsigned*)(ws + WS_END), xb_st); } \
  }
#define PHASE_NB(k, ...)                                                                  \
  if (ph_lo <= (k) && (k) < ph_hi) {                                                      \
    const Params p = load_params();                                                       \
    const int tix = make_tid(wave_s);                                                     \
    unsigned char* ws = p.ws;                                                             \
    (void)ws;                                                                             \
    { __VA_ARGS__ }                                                                       \
  }
  PHASE(0, phase_prep(tix, p, smem, 0, blockIdx.x, gridDim.x);)
  PHASE_NB(1, EpiIn e{p.b_in, ws, p.out};
           gemm_phase(tix, (const u16*)(ws + OFF_XB), (const u16*)(ws + OFF_WIN), NT, 3328, 1024, e, smem);)
  PHASE(1, { const int rem = 884 % (int)gridDim.x;
             if (rem == 0) phase_prep(tix, p, smem, 1, blockIdx.x, gridDim.x);
             else if ((int)blockIdx.x >= rem) phase_prep(tix, p, smem, 1, blockIdx.x - rem, gridDim.x - rem); })
  PHASE(2, for (int it = blockIdx.x; it < 256 + 256 + 256; it += gridDim.x) {
             if (it < 256) attn_prompt_item(tix, p, it, smem);
             else if (it < 512) attn_sample_item(tix, p, it - 256, smem);
             else s5a_item(tix, p, it - 512);
           })
  PHASE_NB(3, EpiUp e{(const u16*)(ws + OFF_GA), (u16*)(ws + OFF_MS)};
           gemm_phase(tix, (const u16*)(ws + OFF_AO), (const u16*)(ws + OFF_WUP), NT, 1024, 512, e, smem);)
  PHASE(3, phase_carry(tix, p);)
  PHASE(4, for (int it = blockIdx.x; it < 256; it += gridDim.x) s5c_item(tix, p, it, smem);)
  PHASE(5, EpiGlu e{p.b_glu, (const u16*)(ws + OFF_MS), (u16*)(ws + OFF_GS)};
           gemm_phase(tix, (const u16*)(ws + OFF_HG), (const u16*)(ws + OFF_WGLU), NT, 2048, 512, e, smem);
           { const int rem = 544 % (int)gridDim.x;
             if (rem == 0) phase_conv(tix, p, blockIdx.x, gridDim.x, 0);
             else if ((int)blockIdx.x >= rem) phase_conv(tix, p, blockIdx.x - rem, gridDim.x - rem, 0); })
  PHASE(6, EpiOut e{p.x_prompt, p.x_sample, (u16*)(ws + OFF_RX)};
           gemm_phase(tix, (const u16*)(ws + OFF_MERGED), (const u16*)(ws + OFF_WOUT), NT, 1024, 1024, e, smem);
           { const int rem = 272 % (int)gridDim.x;
             if (rem == 0) phase_conv(tix, p, blockIdx.x, gridDim.x, 1);
             else if ((int)blockIdx.x >= rem) phase_conv(tix, p, blockIdx.x - rem, gridDim.x - rem, 1); })
  PHASE(7, phase_ln1(tix, p);)
  PHASE(8, EpiSc e{(_Float16*)(ws + OFF_SC)};
           gemm_phase(tix, (const u16*)(ws + OFF_X1B), (const u16*)(ws + OFF_WPQ), NT, 2048, 1024, e, smem);
           )
  PHASE(9, phase_peer(tix, p, smem);)
}

extern "C" void kernel_launch(void* const* d_in, const int* in_sizes, int n_in, void* d_out, int out_size, void* d_ws,
                              size_t ws_size, hipStream_t stream) {
  static int grid = 0;
  if (grid == 0) {
    if (n_in != 30 || ws_size < WS_END + XCD_BAR_WORDS * 4) {
      fprintf(stderr, "kernel_launch: need 30 inputs and %zu ws bytes; got %d, %zu\n", (size_t)WS_END, n_in, ws_size);
      grid = -1;
      return;
    }
    int dev = 0, cus = 0, per_cu = 0;
    hipGetDevice(&dev);
    hipDeviceGetAttribute(&cus, hipDeviceAttributeMultiprocessorCount, dev);
    if (hipFuncSetAttribute((const void*)mega, hipFuncAttributeMaxDynamicSharedMemorySize, LDS_BYTES) != hipSuccess) {
      fprintf(stderr, "kernel_launch: hipFuncSetAttribute failed\n");
      grid = -1;
      return;
    }
    hipOccupancyMaxActiveBlocksPerMultiprocessor(&per_cu, (const void*)mega, 512, LDS_BYTES);
    if (per_cu < 1) { fprintf(stderr, "kernel_launch: occupancy query says %d\n", per_cu); per_cu = 1; }
    (void)hipGetLastError();
    grid = cus;
  }
  if (grid < 0) return;
  Params p{};
  void** pp = (void**)&p;
  for (int i = 0; i < 30; ++i) pp[i] = d_in[i];
  pp[30] = d_out;
  pp[31] = d_ws;
#if MEGA
  (void)hipMemsetAsync((unsigned char*)d_ws + WS_END, 0, XCD_BAR_WORDS * 4, stream);
  int lo = 0, hi = NPHASE;
  void* args[] = {&p, &lo, &hi};
  hipError_t e = hipLaunchCooperativeKernel((const void*)mega, dim3(grid), dim3(512), args, LDS_BYTES, stream);
  if (e != hipSuccess) fprintf(stderr, "cooperative launch failed: %s (grid %d)\n", hipGetErrorString(e), grid);
#else
  for (int ph = 0; ph < NPHASE; ++ph) {
    hipLaunchKernelGGL(mega, dim3(grid), dim3(512), LDS_BYTES, stream, p, ph, ph + 1);
  }
#endif
}
```

```cpp
#include <hip/hip_runtime.h>
#include <hip/hip_bf16.h>
#include <hip/hip_cooperative_groups.h>
#include <cstdio>
namespace cg = cooperative_groups;

#ifndef MEGA
#define MEGA 1
#endif
#define REP -1

typedef unsigned short u16;
using bf16x8 = __attribute__((ext_vector_type(8))) short;
using bf16x4 = __attribute__((ext_vector_type(4))) short;
using f32x4 = __attribute__((ext_vector_type(4))) float;
using f32x16 = __attribute__((ext_vector_type(16))) float;
using f32x2 = __attribute__((ext_vector_type(2))) float;

constexpr int NP = 16384, NS = 1024, NT = 17408;
constexpr float ALPHA = 1.189207115002721f;
constexpr int NPHASE = 10;
constexpr int LDS_BYTES = 131072;
constexpr float PU_SCALE = 256.f, PV_SCALE = 512.f;

constexpr size_t R0 = 0, R1 = 71303168, R2 = 142606336, R3 = 213909504, R4 = 249561088;
constexpr size_t OFF_XB = R0, OFF_WIN = R0 + 35651584, OFF_EB = R0 + 42467328, OFF_TB = R0 + 44564480,
                 OFF_TBS = R0 + 50855936, OFF_HIN = R0 + 52953088, OFF_MS = R0, OFF_RX = R0;
constexpr size_t OFF_GS = R1, OFF_GA = R1 + 35651584, OFF_MERGED = R1, OFF_PU = R1 + 35651584, OFF_PV = R1 + 35651584 + 16777216;
constexpr size_t OFF_ZU = R2, OFF_ZQ = R2 + 17825792, OFF_ZK = R2 + 35651584, OFF_ZV = R2 + 40108032,
                 OFF_SLOC = R2 + 44564480, OFF_SC = R2;
constexpr size_t OFF_AO = R3, OFF_HG = R3 + 17825792, OFF_X1B = R3;
constexpr size_t OFF_WGLU = R4, OFF_WUP = R4 + 2097152, OFF_WOUT = R4 + 3145728, OFF_WPQ = R4 + 5242880,
                 OFF_ROPE = R4 + 9437184, OFF_LAM = R4 + 9699840, WS_END = R4 + 9732608;

constexpr long O_Y = 0, O_KWP = 17825792, O_VWP = O_KWP + 65536, O_HRP = O_VWP + 65536, O_HIP = O_HRP + 8192,
               O_KWS = O_HIP + 8192, O_VWS = O_KWS + 2097152, O_HRS = O_VWS + 2097152, O_HIS = O_HRS + 262144;

#if defined(__HIP_DEVICE_COMPILE__)
#define GPTR __attribute__((address_space(1)))
#else
#define GPTR
#endif
struct Params {
  const GPTR float *x_prompt, *x_sample, *cache_k, *cache_v, *st_re, *st_im, *w_in, *b_in, *a_re, *a_im, *log_dt, *b_re, *b_im,
      *c_re, *c_im, *ssm_d, *w_glu, *b_glu, *sinks, *w_up, *w_out, *ln1_g, *ln1_b, *peer_wq, *peer_k1, *peer_k2, *peer_u,
      *peer_v, *ln2_g, *ln2_b;
  GPTR float* out;
  GPTR unsigned char* ws;
};

typedef __bf16 hwbf16x2 __attribute__((ext_vector_type(2)));
__device__ __forceinline__ unsigned pack2(float a, float b) {
  const f32x2 f = {a, b};
  const hwbf16x2 v = __builtin_convertvector(f, hwbf16x2);
  return __builtin_bit_cast(unsigned, v);
}
__device__ __forceinline__ u16 f2bf(float f) { return (u16)(pack2(f, 0.f) & 0xffffu); }
__device__ __forceinline__ float bf2f(u16 h) { return __uint_as_float(((unsigned)h) << 16); }
typedef float ntf4 __attribute__((ext_vector_type(4)));
__device__ __forceinline__ float4 ldnt4(const float* p) {
  const ntf4 v = __builtin_nontemporal_load((const ntf4*)p);
  return make_float4(v[0], v[1], v[2], v[3]);
}
__device__ __forceinline__ float sigm(float x) { return __builtin_amdgcn_rcpf(1.f + __expf(-x)); }
__device__ __forceinline__ float gelu_(float x) {
  const float ax = fabsf(x) * 0.70710678118654752f;
  const float t = __builtin_amdgcn_rcpf(1.f + 0.3275911f * ax);
  const float poly = t * (0.254829592f + t * (-0.284496736f + t * (1.421413741f + t * (-1.453152027f + t * 1.061405429f))));
  const float er = copysignf(1.f - poly * __expf(-ax * ax), x);
  return 0.5f * x * (1.f + er);
}
__device__ __forceinline__ float wave_max(float v) {
  for (int o = 32; o >= 1; o >>= 1) v = fmaxf(v, __shfl_xor(v, o));
  return v;
}
__device__ __forceinline__ float wave_sum(float v) {
  for (int o = 32; o >= 1; o >>= 1) v += __shfl_xor(v, o);
  return v;
}


template <int CTRL>
__device__ __forceinline__ float dpp_f(float v) {
  return __int_as_float(__builtin_amdgcn_update_dpp(0, __float_as_int(v), CTRL, 0xf, 0xf, false));
}
__device__ __forceinline__ float row_sum16(float v) {
  v += dpp_f<0x128>(v); v += dpp_f<0x124>(v); v += dpp_f<0x122>(v); v += dpp_f<0x121>(v);
  return v;
}
__device__ __forceinline__ float row_max16(float v) {
  v = fmaxf(v, dpp_f<0x128>(v)); v = fmaxf(v, dpp_f<0x124>(v)); v = fmaxf(v, dpp_f<0x122>(v)); v = fmaxf(v, dpp_f<0x121>(v));
  return v;
}
__device__ __forceinline__ float rlane(float v, int l) { return __int_as_float(__builtin_amdgcn_readlane(__float_as_int(v), l)); }
__device__ __forceinline__ float wsum(float v) {
  v = row_sum16(v);
  return (rlane(v, 0) + rlane(v, 16)) + (rlane(v, 32) + rlane(v, 48));
}
__device__ __forceinline__ int mbcnt64(unsigned long long m) {
  return __builtin_amdgcn_mbcnt_hi((unsigned)(m >> 32), __builtin_amdgcn_mbcnt_lo((unsigned)m, 0));
}
#define XB_TMO      128
#define XB_XCNT(j)  (256  + 64 * (j))
#define XB_XSUB(j)  (1280 + 64 * (j))
#define XB_XGEN(j)  (2304 + 64 * (j))
#define XB_TOP      3328
#define XB_TOPGEN   3392
#define XCD_BAR_WORDS 3456
#define XB_SPIN_CAP (1u << 18)
#define LAS __attribute__((address_space(3)))
__device__ __forceinline__ unsigned xb_ld(unsigned* p) { return __hip_atomic_load(p, __ATOMIC_RELAXED, __HIP_MEMORY_SCOPE_AGENT); }
__device__ __forceinline__ unsigned xb_add(unsigned* p, unsigned v) { return __hip_atomic_fetch_add(p, v, __ATOMIC_RELAXED, __HIP_MEMORY_SCOPE_AGENT); }
__device__ __forceinline__ unsigned xb_xcc_id() { return (unsigned)__builtin_amdgcn_s_getreg((3 << 11) | 20) & 0xFu; }
#define XB_SPIN(cond, bar) do { unsigned _sp = 0; while (cond) { __builtin_amdgcn_s_sleep(1); \
    if ((++_sp & 255u) == 0u) { if (xb_ld(&(bar)[XB_TMO])) break; if (_sp > XB_SPIN_CAP) { atomicAdd(&(bar)[XB_TMO], 1u); break; } } } } while (0)
__device__ __forceinline__ void xcd_barrier_complete(unsigned* bar, unsigned x, unsigned& nloc, unsigned& nx) {
  const unsigned G = gridDim.x;
  unsigned sum, cnt, mine, sp = 0u;
  for (;;) {
    sum = 0u; cnt = 0u; mine = 0u;
#pragma unroll
    for (unsigned j = 0; j < 16; ++j) { const unsigned c = xb_ld(&bar[XB_XCNT(j)]); sum += c; cnt += (c > 0u) ? 1u : 0u; mine = (j == x) ? c : mine; }
    if (sum == G) break;
    __builtin_amdgcn_s_sleep(1);
    if ((++sp & 255u) == 0u) { if (xb_ld(&bar[XB_TMO])) break; if (sp > XB_SPIN_CAP) { atomicAdd(&bar[XB_TMO], 1u); break; } }
  }
  nloc = mine > 0u ? mine : 1u; nx = cnt > 0u ? cnt : 1u;
}
__device__ __forceinline__ void gbar(const int tix, unsigned* bar, volatile LAS unsigned* st) {
  asm volatile("s_waitcnt vmcnt(0)" ::: "memory");
  __syncthreads();
  if (tix == 0) {
    __builtin_amdgcn_s_waitcnt(0);
    const unsigned x = xb_xcc_id();
    unsigned nloc = st[0], nx = st[1];
    if (nloc == 0u) { xcd_barrier_complete(bar, x, nloc, nx); st[0] = nloc; st[1] = nx; }
    const unsigned old = xb_add(&bar[XB_XSUB(x)], 1u);
    const unsigned gen = old / nloc;
    if (old + 1u == (gen + 1u) * nloc) {
      __builtin_amdgcn_fence(__ATOMIC_RELEASE, "agent");
      asm volatile("s_waitcnt vmcnt(0)" ::: "memory");
      const unsigned og = xb_add(&bar[XB_TOP], 1u);
      const unsigned tg = og / nx;
      if (og + 1u == (tg + 1u) * nx) xb_add(&bar[XB_TOPGEN], 1u);
      else XB_SPIN(xb_ld(&bar[XB_TOPGEN]) == tg, bar);
      __builtin_amdgcn_fence(__ATOMIC_ACQUIRE, "agent");
      xb_add(&bar[XB_XGEN(x)], 1u);
      asm volatile("s_waitcnt vmcnt(0)" ::: "memory");
    } else {
      XB_SPIN(xb_ld(&bar[XB_XGEN(x)]) == gen, bar);
      __builtin_amdgcn_fence(__ATOMIC_ACQUIRE, "agent");
      asm volatile("s_waitcnt vmcnt(0)" ::: "memory");
    }
  }
  __syncthreads();
}

__device__ __forceinline__ bf16x8 cvt8(const float* src) {
  float4 a = *(const float4*)src, b = *(const float4*)(src + 4);
  union { bf16x8 v; unsigned u[4]; } c;
  c.u[0] = pack2(a.x, a.y); c.u[1] = pack2(a.z, a.w); c.u[2] = pack2(b.x, b.y); c.u[3] = pack2(b.z, b.w);
  return c.v;
}

__device__ __forceinline__ void phase_prep(const int tix, const Params& p, unsigned char* smem, const int part, const int wk, const int nwk) {
  const long T = (long)nwk * 512;
  const long tid = (long)wk * 512 + tix;
  const int wid = tix >> 6, lane = tix & 63;
  unsigned char* ws = p.ws;
  if (part == 0) {
    u16* xb = (u16*)(ws + OFF_XB);
    for (long i = tid; i < (long)NT * 256; i += T) {
      long e = i * 4;
      const float* src = e < (long)NP * 1024 ? p.x_prompt + e : p.x_sample + (e - (long)NP * 1024);
      float4 v = ldnt4(src);
      uint2 o;
      o.x = pack2(v.x, v.y);
      o.y = pack2(v.z, v.w);
      *(uint2*)(xb + e) = o;
    }
  }
  if (part == 1) {
    for (long i = tid; i < 128L * 3840; i += T) {
      long b = i / 3840, r = (i % 3840) * 4;
      *(float4*)(p.out + O_KWS + b * 16384 + r) = *(const float4*)(p.cache_k + b * 16384 + 1024 + r);
      *(float4*)(p.out + O_VWS + b * 16384 + r) = *(const float4*)(p.cache_v + b * 16384 + 1024 + r);
    }
  }
  if (part == 0) {
    float* rt = (float*)(ws + OFF_ROPE);
    for (long i = tid; i < 4104L * 8; i += T) {
      int pi = (int)(i / 8), f = (int)(i % 8);
      double pos = pi < 4096 ? (double)pi : (double)(8192 + pi - 4096);
      double fr = exp(-log(500000.0) * (double)f / 8.0);
      double s, c;
      sincos(pos * fr, &s, &c);
      rt[i * 2] = (float)c;
      rt[i * 2 + 1] = (float)s;
    }
  }
  {
    float* tile = (float*)smem;
    for (int t = (part == 0 ? wk : 832 + wk); t < (part == 0 ? 832 : 1472); t += nwk) {
      const float* src; u16* dst; int K, N, tt, mode = 0;
      if (t < 832) { src = p.w_in; dst = (u16*)(ws + OFF_WIN); K = 1024; N = 3328; tt = t; }
      else if (t < 1088) { src = p.w_glu; dst = (u16*)(ws + OFF_WGLU); K = 512; N = 2048; tt = t - 832; mode = 1; }
      else if (t < 1216) { src = p.w_up; dst = (u16*)(ws + OFF_WUP); K = 512; N = 1024; tt = t - 1088; }
      else { src = p.w_out; dst = (u16*)(ws + OFF_WOUT); K = 1024; N = 1024; tt = t - 1216; }
      const int ntn = N / 64, kt = tt / ntn, nt_ = tt % ntn;
      __syncthreads();
#pragma unroll
      for (int i = 0; i < 2; ++i) {
        int idx = tix + 512 * i, r = idx >> 4, c4 = idx & 15;
        float4 v = *(const float4*)(src + (long)(kt * 64 + r) * N + nt_ * 64 + c4 * 4);
        tile[r * 65 + c4 * 4] = v.x; tile[r * 65 + c4 * 4 + 1] = v.y; tile[r * 65 + c4 * 4 + 2] = v.z; tile[r * 65 + c4 * 4 + 3] = v.w;
      }
      __syncthreads();
      {
        int n = tix & 63, ks = tix >> 6;
        float f[8];
#pragma unroll
        for (int j = 0; j < 8; ++j) f[j] = tile[(ks * 8 + j) * 65 + n];
        int c = nt_ * 64 + n;
        int row = c;
        if (mode == 1) row = (c < 1024) ? ((c >> 7) * 256 + (c & 127)) : (((c - 1024) >> 7) * 256 + 128 + (c & 127));
        uint4 o;
        o.x = pack2(f[0], f[1]); o.y = pack2(f[2], f[3]); o.z = pack2(f[4], f[5]); o.w = pack2(f[6], f[7]);
        *(uint4*)(dst + (long)row * K + kt * 64 + ks * 8) = o;
      }
    }
    __syncthreads();
  }
  if (part == 1) {
    u16* w = (u16*)(ws + OFF_WPQ);
    const int r = lane & 15, fq = lane >> 4;
    for (int task = wk * 8 + wid; task < 2048; task += nwk * 8) {
      const int ntile = task >> 4, ms = task & 15, n0 = ntile * 16;
      const int h = n0 >> 8, half = (n0 >> 7) & 1, key0 = n0 & 127;
      const float* kp = (half ? p.peer_k2 : p.peer_k1) + (long)(h * 128 + key0 + r) * 64 + fq * 8;
      bf16x8 a0 = cvt8(kp), a1 = cvt8(kp + 32);
#pragma unroll
      for (int mt = 0; mt < 4; ++mt) {
        const int m = ms * 64 + mt * 16 + r;
        const float* wq = p.peer_wq + (long)m * 1024 + h * 128 + half * 64 + fq * 8;
        bf16x8 b0 = cvt8(wq), b1 = cvt8(wq + 32);
        f32x4 acc = {0.f, 0.f, 0.f, 0.f};
        acc = __builtin_amdgcn_mfma_f32_16x16x32_bf16(a0, b0, acc, 0, 0, 0);
        acc = __builtin_amdgcn_mfma_f32_16x16x32_bf16(a1, b1, acc, 0, 0, 0);
#pragma unroll
        for (int j = 0; j < 4; ++j) w[(long)(n0 + fq * 4 + j) * 1024 + m] = f2bf(acc[j]);
      }
    }
  }
  if (part == 1) {
    float* lamr = (float*)smem;
    float* lami = lamr + 64 * 17;
    float* qre = lami + 64 * 17;
    float* qim = qre + 64;
    u16* EB = (u16*)(ws + OFF_EB);
    u16* TB = (u16*)(ws + OFF_TB);
    u16* TBS = (u16*)(ws + OFF_TBS);
    float* lm = (float*)(ws + OFF_LAM);
    for (int vb = wk; vb < 256; vb += nwk) {
      const int g = vb >> 3, slice = vb & 7;
      const double dt = exp((double)p.log_dt[g]);
      __syncthreads();
      for (int idx = tix; idx < 64 * 17; idx += 512) {
        int pp = idx / 17, tau = idx % 17;
        double ar = p.a_re[g * 64 + pp], ai = p.a_im[g * 64 + pp];
        double sn, cs, mg = exp((double)tau * ar * dt);
        sincos((double)tau * ai * dt, &sn, &cs);
        lamr[idx] = (float)(mg * cs);
        lami[idx] = (float)(mg * sn);
      }
      if (tix < 64) {
        int pp = tix;
        double ar = p.a_re[g * 64 + pp], ai = p.a_im[g * 64 + pp];
        double sn, cs, mg = exp(ar * dt);
        sincos(ai * dt, &sn, &cs);
        double nr = mg * cs - 1.0, ni = mg * sn, den = ar * ar + ai * ai;
        qre[pp] = (float)((nr * ar + ni * ai) / den);
        qim[pp] = (float)((ni * ar - nr * ai) / den);
      }
      __syncthreads();
      {
        int item = slice * 512 + tix, co = item >> 8, ci = (item >> 4) & 15, tau = item & 15;
        float K = 0.f;
        for (int pp = 0; pp < 64; ++pp) {
          float br = p.b_re[(long)(g * 64 + pp) * 16 + ci], bi = p.b_im[(long)(g * 64 + pp) * 16 + ci];
          float Br = qre[pp] * br - qim[pp] * bi, Bi = qre[pp] * bi + qim[pp] * br;
          float cr = p.c_re[(long)(g * 16 + co) * 64 + pp], cim = p.c_im[(long)(g * 16 + co) * 64 + pp];
          float wr = cr * Br - cim * Bi, wi = cr * Bi + cim * Br;
          K += wr * lamr[pp * 17 + tau] - wi * lami[pp * 17 + tau];
        }
        if (tau == 0 && co == ci) K += p.ssm_d[g * 16 + co];
        u16 kb = f2bf(K);
        for (int t = tau; t < 16; ++t) TB[((long)g * 256 + t * 16 + co) * 384 + (t - tau) * 16 + ci] = kb;
        if (tau >= 1)
          for (int t = 0; t + tau < 16; ++t) TB[((long)g * 256 + t * 16 + co) * 384 + (t + tau) * 16 + ci] = 0;
      }
#pragma unroll 1
      for (int i = 0; i < 4; ++i) {
        int item = slice * 2048 + tix + 512 * i, pp = item >> 8, s_ = (item >> 4) & 15, c = item & 15;
        float lr = lamr[pp * 17 + 15 - s_], li = lami[pp * 17 + 15 - s_];
        float fr = lr * qre[pp] - li * qim[pp], fi = lr * qim[pp] + li * qre[pp];
        float br = p.b_re[(long)(g * 64 + pp) * 16 + c], bi = p.b_im[(long)(g * 64 + pp) * 16 + c];
        EB[((long)g * 128 + pp) * 256 + s_ * 16 + c] = f2bf(fr * br - fi * bi);
        EB[((long)g * 128 + 64 + pp) * 256 + s_ * 16 + c] = f2bf(fr * bi + fi * br);
      }
#pragma unroll 1
      for (int i = 0; i < 4; ++i) {
        int item = slice * 2048 + tix + 512 * i, co = item >> 10, t = (item >> 6) & 15, pp = item & 63;
        float cr = p.c_re[(long)(g * 16 + co) * 64 + pp], cim = p.c_im[(long)(g * 16 + co) * 64 + pp];
        float lr = lamr[pp * 17 + t + 1], li = lami[pp * 17 + t + 1];
        long row = (long)g * 256 + t * 16 + co;
        TB[row * 384 + 256 + pp] = f2bf(cr * lr - cim * li);
        TB[row * 384 + 320 + pp] = f2bf(-(cr * li + cim * lr));
        if (t >= 8) {
          float l2r = lamr[pp * 17 + t - 7], l2i = lami[pp * 17 + t - 7];
          TBS[row * 128 + pp] = f2bf(cr * l2r - cim * l2i);
          TBS[row * 128 + 64 + pp] = f2bf(-(cr * l2i + cim * l2r));
        } else {
          TBS[row * 128 + pp] = 0;
          TBS[row * 128 + 64 + pp] = 0;
        }
      }
      if (slice == 0 && tix < 64) {
        int pp = tix;
        lm[(g * 64 + pp) * 4 + 0] = lamr[pp * 17 + 16];
        lm[(g * 64 + pp) * 4 + 1] = lami[pp * 17 + 16];
        lm[(g * 64 + pp) * 4 + 2] = lamr[pp * 17 + 8];
        lm[(g * 64 + pp) * 4 + 3] = lami[pp * 17 + 8];
      }
    }
    __syncthreads();
  }
}

constexpr int BM = 256, BK = 64, HALF = 128, NXCD = 8, WGM = 8, HT = HALF * BK;

__device__ __forceinline__ int lds_byte(int r, int c) {
  int st = (r >> 4) * 2 + (c >> 5), rr = r & 15, cc = c & 31, ob = rr * 64 + cc * 2;
  return st * 1024 + (ob ^ (((ob >> 9) & 1) << 5));
}
__device__ __forceinline__ void stage_rc(int b, int& R, int& C) {
  int st = b / 1024, sb = b % 1024, swz = sb ^ (((sb >> 9) & 1) << 5);
  R = (st >> 1) * 16 + swz / 64;
  C = (st & 1) * 32 + (swz % 64) / 2;
}

template <class Epi>
__device__ __forceinline__ void gemm_phase(const int tix, const u16* __restrict__ A, const u16* __restrict__ Bt, int M, int N, int K,
                                           const Epi& epi, unsigned char* smem) {
  u16* shm = (u16*)smem;
#define SA(b, h) (shm + ((b)*2 + (h)) * HT)
#define SB(b, h) (shm + (4 + (b)*2 + (h)) * HT)
#define STAGE(P, BASE, br, kt)                                                                       \
  do {                                                                                               \
    const u16* _gb = (BASE) + (long)(br)*K + (long)(kt)*BK;                                          \
    __builtin_amdgcn_global_load_lds((const unsigned*)(_gb + soff0),                                 \
                                     (__attribute__((address_space(3))) unsigned*)((char*)(P) + tix * 16), 16, 0, 0); \
    __builtin_amdgcn_global_load_lds((const unsigned*)(_gb + soff1),                                 \
                                     (__attribute__((address_space(3))) unsigned*)((char*)(P) + tix * 16 + 8192), 16, 0, 0); \
  } while (0)
#define LDA(dst, b, h)                                                                               \
  for (int m = 0; m < 4; ++m)                                                                        \
    for (int k = 0; k < 2; ++k)                                                                      \
  dst[m][k] = *reinterpret_cast<const bf16x8*>((char*)SA(b, h) + lds_byte(wr * 64 + m * 16 + fr, k * 32 + fq * 8))
#define LDB(dst, b, h)                                                                               \
  for (int n = 0; n < 2; ++n)                                                                        \
    for (int k = 0; k < 2; ++k)                                                                      \
  dst[n][k] = *reinterpret_cast<const bf16x8*>((char*)SB(b, h) + lds_byte(wc * 32 + n * 16 + fr, k * 32 + fq * 8))
#define MMA(ai, bj, At, Bt_)                                                                         \
  do {                                                                                               \
    __builtin_amdgcn_s_setprio(1);                                                                   \
    for (int m = 0; m < 4; ++m)                                                                      \
      for (int n = 0; n < 2; ++n)                                                                    \
        for (int k = 0; k < 2; ++k)                                                                  \
          acc[ai][bj][m][n] =                                                                        \
              __builtin_amdgcn_mfma_f32_16x16x32_bf16(At[m][k], Bt_[n][k], acc[ai][bj][m][n], 0, 0, 0); \
    __builtin_amdgcn_s_setprio(0);                                                                   \
  } while (0)
#define WAIT_V(n) asm volatile("s_waitcnt vmcnt(" #n ")" ::: "memory")
#define WAIT_L(n) asm volatile("s_waitcnt lgkmcnt(" #n ")" ::: "memory")
#define BAR __builtin_amdgcn_s_barrier()
#define SCHED __builtin_amdgcn_sched_barrier(0)

  const int nM = M / BM, nN = N / BM, nwg = nM * nN;
  const int wid = tix >> 6, lane = tix & 63, wr = wid >> 2, wc = wid & 3, fr = lane & 15, fq = lane >> 4;
  const int nt = K / BK;
  for (int wg0 = blockIdx.x; wg0 < nwg; wg0 += gridDim.x) {
    unsigned soff0, soff1;
    {
      int tx_ = tix;
      asm volatile("" : "+v"(tx_));
      int r_, c_;
      stage_rc(tx_ * 16, r_, c_);
      soff0 = (unsigned)(r_ * K + c_);
      stage_rc(tx_ * 16 + 8192, r_, c_);
      soff1 = (unsigned)(r_ * K + c_);
    }
    int wgid = wg0;
    {
      int q = nwg / NXCD, r = nwg % NXCD, xcd = wgid % NXCD, off = wgid / NXCD;
      wgid = (xcd < r ? xcd * (q + 1) : r * (q + 1) + (xcd - r) * q) + off;
    }
    int nig = WGM * nN, gid = wgid / nig, fm = gid * WGM, gsz = min(nM - fm, WGM);
    int pm = fm + ((wgid % nig) % gsz), pn = (wgid % nig) / gsz, brow = pm * BM, bcol = pn * BM;
    f32x4 acc[2][2][4][2] = {};
    bf16x8 At[4][2], B0[2][2], B1[2][2];
    STAGE(SB(0, 0), Bt, bcol, 0);
    STAGE(SA(0, 0), A, brow, 0);
    STAGE(SB(0, 1), Bt, bcol + HALF, 0);
    STAGE(SA(0, 1), A, brow + HALF, 0);
    if (wr == 1) BAR;
    WAIT_V(4);
    BAR;
    STAGE(SB(1, 0), Bt, bcol, 1);
    STAGE(SA(1, 0), A, brow, 1);
    STAGE(SB(1, 1), Bt, bcol + HALF, 1);
    WAIT_V(6);
    BAR;
    for (int t = 0; t < nt - 2; t += 2) {
      LDB(B0, 0, 0); SCHED; LDA(At, 0, 0); STAGE(SA(1, 1), A, brow + HALF, t + 1);
      WAIT_L(8); BAR; WAIT_L(0); MMA(0, 0, At, B0); BAR; SCHED;
      LDB(B1, 0, 1); STAGE(SB(0, 0), Bt, bcol, t + 2);
      BAR; WAIT_L(0); MMA(0, 1, At, B1); BAR;
      LDA(At, 0, 1); STAGE(SA(0, 0), A, brow, t + 2);
      BAR; WAIT_L(0); MMA(1, 0, At, B0); BAR; SCHED;
      STAGE(SB(0, 1), Bt, bcol + HALF, t + 2);
      WAIT_V(6); BAR; MMA(1, 1, At, B1); BAR;
      LDB(B0, 1, 0); SCHED; LDA(At, 1, 0); STAGE(SA(0, 1), A, brow + HALF, t + 2);
      WAIT_L(8); BAR; WAIT_L(0); MMA(0, 0, At, B0); BAR; SCHED;
      LDB(B1, 1, 1); STAGE(SB(1, 0), Bt, bcol, t + 3);
      BAR; WAIT_L(0); MMA(0, 1, At, B1); BAR;
      LDA(At, 1, 1); STAGE(SA(1, 0), A, brow, t + 3);
      BAR; WAIT_L(0); MMA(1, 0, At, B0); BAR; SCHED;
      STAGE(SB(1, 1), Bt, bcol + HALF, t + 3);
      WAIT_V(6); BAR; MMA(1, 1, At, B1); BAR;
    }
    {
      LDB(B0, 0, 0); LDA(At, 0, 0); STAGE(SA(1, 1), A, brow + HALF, nt - 1);
      BAR; WAIT_L(0); MMA(0, 0, At, B0); BAR;
      LDB(B1, 0, 1); BAR; WAIT_L(0); MMA(0, 1, At, B1); BAR;
      LDA(At, 0, 1); WAIT_V(4); BAR; WAIT_L(0); MMA(1, 0, At, B0); MMA(1, 1, At, B1); BAR;
    }
    {
      LDB(B0, 1, 0); LDA(At, 1, 0); WAIT_V(2); BAR; WAIT_L(0); MMA(0, 0, At, B0); BAR;
      LDB(B1, 1, 1); WAIT_V(0); BAR; WAIT_L(0); MMA(0, 1, At, B1); BAR;
      LDA(At, 1, 1); BAR; WAIT_L(0); MMA(1, 0, At, B0); MMA(1, 1, At, B1); BAR;
    }
    if (wr == 0) BAR;
    {
      int brow2 = brow, bcol2 = bcol, pn2 = pn;
      asm volatile("" : "+s"(brow2), "+s"(bcol2), "+s"(pn2));
      float* stg = (float*)smem;
#pragma unroll
      for (int ai = 0; ai < 2; ++ai)
#pragma unroll
        for (int mh = 0; mh < 2; ++mh) {
          __syncthreads();
#pragma unroll
          for (int mq = 0; mq < 2; ++mq)
#pragma unroll
            for (int bj = 0; bj < 2; ++bj)
#pragma unroll
              for (int n = 0; n < 2; ++n)
#pragma unroll
                for (int j = 0; j < 4; ++j)
                  stg[(wr * 32 + mq * 16 + fq * 4 + j) * 260 + bj * 128 + wc * 32 + n * 16 + fr] = acc[ai][bj][mh * 2 + mq][n][j];
          __syncthreads();
          if (Epi::UNROLL) {
#pragma unroll
            for (int i = 0; i < 4; ++i) {
              const int lr = (tix >> 5) + 16 * i, c8 = tix & 31;
              const int tr = ai * 128 + (lr >> 5) * 64 + mh * 32 + (lr & 31);
              epi(brow2 + tr, bcol2, pn2, c8, stg + lr * 260);
            }
          } else {
#pragma unroll 1
            for (int i = 0; i < 4; ++i) {
              const int lr = (tix >> 5) + 16 * i, c8 = tix & 31;
              const int tr = ai * 128 + (lr >> 5) * 64 + mh * 32 + (lr & 31);
              epi(brow2 + tr, bcol2, pn2, c8, stg + lr * 260);
            }
          }
        }
    }
    __syncthreads();
  }
#undef SA
#undef SB
#undef STAGE
#undef LDA
#undef LDB
#undef MMA
}

__device__ __forceinline__ void ld8(const float* p, float* v) {
  float4 a = *(const float4*)p, b = *(const float4*)(p + 4);
  v[0] = a.x; v[1] = a.y; v[2] = a.z; v[3] = a.w; v[4] = b.x; v[5] = b.y; v[6] = b.z; v[7] = b.w;
}
__device__ __forceinline__ void st8f(float* p, const float* v) {
  *(float4*)p = make_float4(v[0], v[1], v[2], v[3]);
  *(float4*)(p + 4) = make_float4(v[4], v[5], v[6], v[7]);
}
__device__ __forceinline__ uint4 pack8(const float* v) {
  uint4 o;
  o.x = pack2(v[0], v[1]); o.y = pack2(v[2], v[3]); o.z = pack2(v[4], v[5]); o.w = pack2(v[6], v[7]);
  return o;
}
__device__ __forceinline__ void unpack8(uint4 u, float* v) {
  v[0] = __uint_as_float(u.x << 16); v[1] = __uint_as_float(u.x & 0xffff0000u);
  v[2] = __uint_as_float(u.y << 16); v[3] = __uint_as_float(u.y & 0xffff0000u);
  v[4] = __uint_as_float(u.z << 16); v[5] = __uint_as_float(u.z & 0xffff0000u);
  v[6] = __uint_as_float(u.w << 16); v[7] = __uint_as_float(u.w & 0xffff0000u);
}

struct EpiIn {
  static constexpr bool UNROLL = false;
  const float* b_in; unsigned char* ws; float* out;
  __device__ __forceinline__ void operator()(int row, int bcol, int pn, int c8, const float* srow) const {
    const float* rope = (const float*)(ws + OFF_ROPE);
    u16 *zu = (u16*)(ws + OFF_ZU), *zq = (u16*)(ws + OFF_ZQ), *zk = (u16*)(ws + OFF_ZK), *zv = (u16*)(ws + OFF_ZV),
        *gs = (u16*)(ws + OFF_GS), *ga = (u16*)(ws + OFF_GA);
    const int col = bcol + c8 * 8;
    float v[8], bb[8];
    ld8(srow + c8 * 8, v);
    ld8(b_in + col, bb);
#pragma unroll
    for (int i = 0; i < 8; ++i) v[i] += bb[i];
    if (pn < 2) {
      *(uint4*)(zu + (long)row * 512 + col) = pack8(v);
    } else if (pn < 5) {
      const bool isq = pn < 4, isk = (pn == 4 && c8 < 16);
      const int d0 = (c8 * 8) & 63;
      const bool dorope = (isq || isk) && d0 < 16;
      const int pi = row < NP ? (row & 4095) : (4096 + ((row - NP) & 7));
#pragma unroll
      for (int hf = 0; hf < 2; ++hf) {
        float cs[8];
        ld8(rope + (long)pi * 16 + hf * 8, cs);
#pragma unroll
        for (int i = 0; i < 4; ++i) {
          float x = v[hf * 4 + i];
          float pv = dpp_f<0xB1>(x);
          float r = (d0 == 0) ? (x * cs[2 * i] - pv * cs[2 * i + 1]) : (x * cs[2 * i] + pv * cs[2 * i + 1]);
          v[hf * 4 + i] = dorope ? r : x;
        }
      }
      if (isq) {
        *(uint4*)(zq + (long)row * 512 + (col - 512)) = pack8(v);
      } else {
        const int kk = (c8 & 15) * 8;
        *(uint4*)((isk ? zk : zv) + (long)row * 128 + kk) = pack8(v);
        const long ob = isk ? O_KWP : O_VWP, os = isk ? O_KWS : O_VWS;
        if (row < NP) {
          const int b = row >> 12, t = row & 4095;
          if (t >= 3968) st8f(out + ob + ((long)(b * 128 + t - 3968)) * 128 + kk, v);
        } else {
          const int r = row - NP, b = r >> 3, s = r & 7;
          st8f(out + os + ((long)(b * 128 + 120 + s)) * 128 + kk, v);
        }
      }
    } else {
#pragma unroll
      for (int i = 0; i < 8; ++i) v[i] = sigm(v[i]);
      if (pn < 9) *(uint4*)(gs + (long)row * 1024 + (col - 1280)) = pack8(v);
      else *(uint4*)(ga + (long)row * 1024 + (col - 2304)) = pack8(v);
    }
  }
};

struct EpiGlu {
  static constexpr bool UNROLL = true;
  const float* b_glu; const u16* ma; u16* gs_merged;
  __device__ __forceinline__ void operator()(int row, int bcol, int pn, int c8, const float* srow) const {
    if (c8 >= 16) return;
    const int ca = pn * 128 + c8 * 8;
    float a[8], b[8], ba[8], bb[8], g[8], m[8];
    ld8(srow + c8 * 8, a);
    ld8(srow + 128 + c8 * 8, b);
    ld8(b_glu + ca, ba);
    ld8(b_glu + 1024 + ca, bb);
    unpack8(*(const uint4*)(gs_merged + (long)row * 1024 + ca), g);
    unpack8(*(const uint4*)(ma + (long)row * 1024 + ca), m);
#pragma unroll
    for (int i = 0; i < 8; ++i) a[i] = m[i] + g[i] * ((a[i] + ba[i]) * sigm(b[i] + bb[i]));
    *(uint4*)(gs_merged + (long)row * 1024 + ca) = pack8(a);
  }
};

struct EpiUp {
  static constexpr bool UNROLL = true;
  const u16* ga; u16* ma;
  __device__ __forceinline__ void operator()(int row, int bcol, int pn, int c8, const float* srow) const {
    const long o = (long)row * 1024 + bcol + c8 * 8;
    float v[8], g[8];
    ld8(srow + c8 * 8, v);
    unpack8(*(const uint4*)(ga + o), g);
#pragma unroll
    for (int i = 0; i < 8; ++i) v[i] = g[i] * v[i];
    *(uint4*)(ma + o) = pack8(v);
  }
};

struct EpiOut {
  static constexpr bool UNROLL = true;
  const float *xp, *xs; u16* rx;
  __device__ __forceinline__ void operator()(int row, int bcol, int pn, int c8, const float* srow) const {
    const long o = (long)row * 1024 + bcol + c8 * 8;
    float v[8], x[8];
    ld8(srow + c8 * 8, v);
    {
      const float* xsrc = row < NP ? xp + o : xs + (o - (long)NP * 1024);
      const float4 xa = ldnt4(xsrc), xb_ = ldnt4(xsrc + 4);
      x[0] = xa.x; x[1] = xa.y; x[2] = xa.z; x[3] = xa.w; x[4] = xb_.x; x[5] = xb_.y; x[6] = xb_.z; x[7] = xb_.w;
    }
#pragma unroll
    for (int i = 0; i < 8; ++i) v[i] = ALPHA * x[i] + v[i];
    *(uint4*)(rx + o) = pack8(v);
  }
};

struct EpiSc {
  static constexpr bool UNROLL = true;
  _Float16* sc;
  __device__ __forceinline__ void operator()(int row, int bcol, int pn, int c8, const float* srow) const {
    float v[8];
    ld8(srow + c8 * 8, v);
    union { uint4 u; _Float16 h[8]; } o;
#pragma unroll
    for (int i = 0; i < 8; ++i) o.h[i] = (_Float16)v[i];
    *(uint4*)(sc + (long)row * 2048 + bcol + c8 * 8) = o.u;
  }
};

__device__ __forceinline__ bf16x8 s5_load_u(const u16* zu, int crow, int g, int s, int ch) {
  const bool smp = crow >= 1024, valid = !smp || s >= 8;
  long tok = smp ? (long)NP + (long)(crow - 1024) * 8 + (s - 8) : (long)crow * 16 + s;
  tok = valid ? tok : 0;
  union { bf16x8 v; uint4 u; } a;
  a.u = *(const uint4*)(zu + tok * 512 + g * 16 + ch);
  const unsigned m = valid ? 0xffffffffu : 0u;
  a.u.x &= m; a.u.y &= m; a.u.z &= m; a.u.w &= m;
  return a.v;
}

__device__ __forceinline__ int s5_tile_row0(int slice, int i) { return i < 8 ? (slice * 8 + i) * 16 : 1024 + slice * 16; }

__device__ __forceinline__ void s5a_item(const int tix, const Params& p, int item) {
  const int g = item >> 3, slice = item & 7;
  const int wid = tix >> 6, lane = tix & 63, r = lane & 15, fq = lane >> 4;
  const u16* zu = (const u16*)(p.ws + OFF_ZU);
  const u16* EB = (const u16*)(p.ws + OFF_EB);
  float* sloc = (float*)(p.ws + OFF_SLOC);
  bf16x8 bfr[8];
#pragma unroll
  for (int kk = 0; kk < 8; ++kk) bfr[kk] = *(const bf16x8*)(EB + ((long)g * 128 + wid * 16 + r) * 256 + kk * 32 + fq * 8);
  bf16x8 a[8], an[8];
#pragma unroll
  for (int kk = 0; kk < 8; ++kk) a[kk] = s5_load_u(zu, s5_tile_row0(slice, 0) + r, g, kk * 2 + (fq >> 1), (fq & 1) * 8);
#pragma unroll 1
  for (int i = 0; i < 9; ++i) {
    const int row0 = s5_tile_row0(slice, i);
    if (i + 1 < 9) {
      const int rown = s5_tile_row0(slice, i + 1);
#pragma unroll
      for (int kk = 0; kk < 8; ++kk) an[kk] = s5_load_u(zu, rown + r, g, kk * 2 + (fq >> 1), (fq & 1) * 8);
    }
    f32x4 acc = {0.f, 0.f, 0.f, 0.f};
#pragma unroll
    for (int kk = 0; kk < 8; ++kk) acc = __builtin_amdgcn_mfma_f32_16x16x32_bf16(a[kk], bfr[kk], acc, 0, 0, 0);
#pragma unroll
    for (int j = 0; j < 4; ++j) sloc[((long)(row0 + fq * 4 + j) * 32 + g) * 128 + wid * 16 + r] = acc[j];
#pragma unroll
    for (int kk = 0; kk < 8; ++kk) a[kk] = an[kk];
  }
}

__device__ __forceinline__ bf16x8 s5c_load_a(const u16* zu, const u16* hin, int crow, int g, int kk, int fq) {
  const bool isu = kk < 8;
  const int s = (kk & 7) * 2 + (fq >> 1), ch = (fq & 1) * 8;
  const bool smp = crow >= 1024, valid = !isu || !smp || s >= 8;
  long tok = smp ? (long)NP + (long)(crow - 1024) * 8 + (s - 8) : (long)crow * 16 + s;
  tok = valid ? tok : 0;
  const u16* pu_ = zu + tok * 512 + g * 16 + ch;
  const u16* ph_ = hin + ((long)crow * 32 + g) * 128 + ((kk - 8) & 3) * 32 + fq * 8;
  union { bf16x8 v; uint4 u; } a;
  a.u = *(const uint4*)(isu ? pu_ : ph_);
  const unsigned m = valid ? 0xffffffffu : 0u;
  a.u.x &= m; a.u.y &= m; a.u.z &= m; a.u.w &= m;
  return a.v;
}

constexpr int S5C_ROWB = 784;
__device__ __forceinline__ void s5c_item(const int tix, const Params& p, int item, unsigned char* smem) {
  const int g = item >> 3, slice = item & 7;
  const int wid = tix >> 6, lane = tix & 63, r = lane & 15, fq = lane >> 4;
  const u16* zu = (const u16*)(p.ws + OFF_ZU);
  const u16* TB = (const u16*)(p.ws + OFF_TB);
  const u16* TBS = (const u16*)(p.ws + OFF_TBS);
  const u16* hin = (const u16*)(p.ws + OFF_HIN);
  u16* hg = (u16*)(p.ws + OFF_HG);
  __syncthreads();
#pragma unroll 1
  for (int hb = 0; hb < 2; ++hb) {
    bf16x8 v[7];
#pragma unroll
    for (int t = 0; t < 7; ++t) {
      int idx = tix + 512 * (hb * 7 + t);
      idx = idx < 6912 ? idx : 6911;
      const int i = idx / 768, rem = idx % 768, rr = rem / 48, pc = rem % 48;
      v[t] = s5c_load_a(zu, hin, s5_tile_row0(slice, i) + rr, g, pc >> 2, pc & 3);
    }
#pragma unroll
    for (int t = 0; t < 7; ++t) {
      int idx = tix + 512 * (hb * 7 + t);
      idx = idx < 6912 ? idx : 6911;
      const int i = idx / 768, rem = idx % 768, rr = rem / 48, pc = rem % 48;
      *(bf16x8*)(smem + (i * 16 + rr) * S5C_ROWB + pc * 16) = v[t];
    }
  }
  bf16x8 bfr[12][2];
#pragma unroll
  for (int kk = 0; kk < 12; ++kk)
#pragma unroll
    for (int q = 0; q < 2; ++q)
      bfr[kk][q] = *(const bf16x8*)(TB + ((long)g * 256 + (wid * 2 + q) * 16 + r) * 384 + kk * 32 + fq * 8);
  __syncthreads();
  bf16x8 a[12];
#pragma unroll 1
  for (int i = 0; i < 9; ++i) {
    const int row0 = s5_tile_row0(slice, i);
#pragma unroll
    for (int kk = 0; kk < 12; ++kk) a[kk] = *(const bf16x8*)(smem + (i * 16 + r) * S5C_ROWB + (kk * 4 + fq) * 16);
    if (i == 8) {
#pragma unroll
      for (int kk = 8; kk < 12; ++kk)
#pragma unroll
        for (int q = 0; q < 2; ++q)
          bfr[kk][q] = *(const bf16x8*)(TBS + ((long)g * 256 + (wid * 2 + q) * 16 + r) * 128 + (kk - 8) * 32 + fq * 8);
    }
    f32x4 acc[2];
    acc[0] = (f32x4){0.f, 0.f, 0.f, 0.f};
    acc[1] = (f32x4){0.f, 0.f, 0.f, 0.f};
#pragma unroll
    for (int kk = 0; kk < 12; ++kk)
#pragma unroll
      for (int q = 0; q < 2; ++q) acc[q] = __builtin_amdgcn_mfma_f32_16x16x32_bf16(a[kk], bfr[kk][q], acc[q], 0, 0, 0);
#pragma unroll
    for (int q = 0; q < 2; ++q) {
      const int nt = wid * 2 + q;
#pragma unroll
      for (int j = 0; j < 4; ++j) {
        const int cr = row0 + fq * 4 + j;
        long tok;
        if (i < 8) tok = (long)cr * 16 + nt;
        else {
          if (nt < 8) continue;
          tok = (long)NP + (long)(cr - 1024) * 8 + (nt - 8);
        }
        hg[tok * 512 + g * 16 + r] = f2bf(gelu_(acc[q][j]));
      }
    }
  }
}

__device__ __forceinline__ void phase_carry(const int tix, const Params& p) {
  const long T = (long)gridDim.x * 512;
  const long tid = (long)blockIdx.x * 512 + tix;
  const float* lm = (const float*)(p.ws + OFF_LAM);
  const float* sloc = (const float*)(p.ws + OFF_SLOC);
  u16* hin = (u16*)(p.ws + OFF_HIN);
  for (long i = tid; i < 262144; i += T) {
    int b = (int)(i / 2048), g = (int)((i / 64) % 32), pp = (int)(i % 64);
    float lr = lm[(g * 64 + pp) * 4 + 2], li = lm[(g * 64 + pp) * 4 + 3];
    float hr = p.st_re[i], hi = p.st_im[i];
    long base = ((long)(1024 + b) * 32 + g) * 128;
    hin[base + pp] = f2bf(hr);
    hin[base + 64 + pp] = f2bf(hi);
    float sr = sloc[base + pp], si = sloc[base + 64 + pp];
    p.out[O_HRS + i] = lr * hr - li * hi + sr;
    p.out[O_HIS + i] = lr * hi + li * hr + si;
  }
  for (long w = (long)(gridDim.x - 1 - blockIdx.x) + (long)gridDim.x * (tix >> 6); w < 128; w += (long)gridDim.x * 8) {
    const int b = (int)(w >> 5), g = (int)(w & 31), pp = tix & 63;
    const long i = (long)(b * 32 + g) * 64 + pp;
    const float lr = lm[(g * 64 + pp) * 4 + 0], li = lm[(g * 64 + pp) * 4 + 1];
    float hr = 0.f, hi = 0.f;
    float ar_[16], ai_[16], br_[16], bi_[16];
#define CLOAD(R, I, c0)                                                      \
  _Pragma("unroll") for (int u = 0; u < 16; ++u) {                           \
    long base = ((long)(b * 256 + (c0) + u) * 32 + g) * 128;                 \
    R[u] = sloc[base + pp];                                                  \
    I[u] = sloc[base + 64 + pp];                                             \
  }
#define CSTEP(R, I, c0)                                                      \
  _Pragma("unroll") for (int u = 0; u < 16; ++u) {                           \
    long base = ((long)(b * 256 + (c0) + u) * 32 + g) * 128;                 \
    hin[base + pp] = f2bf(hr);                                               \
    hin[base + 64 + pp] = f2bf(hi);                                          \
    float nr = lr * hr - li * hi + R[u], ni = lr * hi + li * hr + I[u];      \
    hr = nr;                                                                 \
    hi = ni;                                                                 \
  }
    CLOAD(ar_, ai_, 0)
#pragma unroll 1
    for (int c0 = 0; c0 < 256; c0 += 32) {
      CLOAD(br_, bi_, c0 + 16)
      CSTEP(ar_, ai_, c0)
      if (c0 + 32 < 256) { CLOAD(ar_, ai_, c0 + 32) }
      CSTEP(br_, bi_, c0 + 16)
    }
#undef CLOAD
#undef CSTEP
    p.out[O_HRP + i] = hr;
    p.out[O_HIP + i] = hi;
  }
}

constexpr int KS_STRIDE = 72;
constexpr int VT_STRIDE = 264;

__device__ __forceinline__ void attn_prompt_item(const int tix, const Params& p, int item, unsigned char* smem) {
  const int b = item >> 6, kvh = (item >> 5) & 1, qb = item & 31;
  const int wid = tix >> 6, lane = tix & 63, r = lane & 31, h = lane >> 5;
  const u16* zq = (const u16*)(p.ws + OFF_ZQ);
  const u16* zk = (const u16*)(p.ws + OFF_ZK);
  const u16* zv = (const u16*)(p.ws + OFF_ZV);
  u16* ao = (u16*)(p.ws + OFF_AO);
  u16* Ks = (u16*)smem;
  u16* Vt = (u16*)(smem + 256 * KS_STRIDE * 2);
  const int T0 = qb * 128;
  __syncthreads();
  for (int i = tix; i < 2048; i += 512) {
    int key = i >> 3, seg = i & 7;
    int pos = T0 - 128 + key;
    uint4 kv = {0, 0, 0, 0}, vv = {0, 0, 0, 0};
    if (pos >= 0) {
      long tok = (long)b * 4096 + pos;
      kv = *(const uint4*)(zk + tok * 128 + kvh * 64 + seg * 8);
      vv = *(const uint4*)(zv + tok * 128 + kvh * 64 + seg * 8);
    }
    *(uint4*)(Ks + key * KS_STRIDE + seg * 8) = kv;
    unsigned w[4] = {vv.x, vv.y, vv.z, vv.w};
#pragma unroll
    for (int e = 0; e < 4; ++e) {
      Vt[(seg * 8 + e * 2) * VT_STRIDE + key] = (u16)(w[e] & 0xffff);
      Vt[(seg * 8 + e * 2 + 1) * VT_STRIDE + key] = (u16)(w[e] >> 16);
    }
  }
  __syncthreads();
  const int hq = kvh * 4 + (wid >> 1), qh = wid & 1;
  const float sink = p.sinks[hq];
#pragma unroll 1
  for (int ng = 0; ng < 2; ++ng) {
    const int q0 = qh * 64 + ng * 32, qi = q0 + r;
    const long tok = (long)b * 4096 + T0 + qi;
    bf16x8 qf[4];
#pragma unroll
    for (int kk = 0; kk < 4; ++kk) qf[kk] = *(const bf16x8*)(zq + tok * 512 + hq * 64 + kk * 16 + 8 * h);
    f32x16 oacc[2];
#pragma unroll
    for (int a = 0; a < 2; ++a)
#pragma unroll
      for (int i = 0; i < 16; ++i) oacc[a][i] = 0.f;
    float mrun = sink, lrun = 1.f;
#pragma unroll 1
    for (int kt = 0; kt < 5; ++kt) {
      const int sjb = q0 + kt * 32;
      f32x16 sacc;
#pragma unroll
      for (int i = 0; i < 16; ++i) sacc[i] = 0.f;
#pragma unroll
      for (int kk = 0; kk < 4; ++kk) {
        bf16x8 kf = *(const bf16x8*)(Ks + (sjb + r) * KS_STRIDE + kk * 16 + 8 * h);
        sacc = __builtin_amdgcn_mfma_f32_32x32x16_bf16(kf, qf[kk], sacc, 0, 0, 0);
      }
      float mx = -3.0e38f;
#pragma unroll
      for (int i = 0; i < 16; ++i) {
        int sj = sjb + 8 * (i >> 2) + 4 * h + (i & 3);
        bool valid = (sj > qi) && (sj <= qi + 128) && (qb > 0 || sj >= 128);
        float s = valid ? sacc[i] * 0.125f : -1.0e30f;
        sacc[i] = s;
        mx = fmaxf(mx, s);
      }
      mx = fmaxf(mx, __shfl_xor(mx, 32));
      float mnew = fmaxf(mrun, mx);
      float corr = __expf(mrun - mnew);
      float ls = 0.f;
#pragma unroll
      for (int i = 0; i < 16; ++i) {
        float e = __expf(sacc[i] - mnew);
        sacc[i] = e;
        ls += e;
      }
      ls += __shfl_xor(ls, 32);
      lrun = lrun * corr + ls;
      mrun = mnew;
#pragma unroll
      for (int dt = 0; dt < 2; ++dt)
#pragma unroll
        for (int i = 0; i < 16; ++i) oacc[dt][i] *= corr;
#pragma unroll
      for (int s = 0; s < 2; ++s) {
        union { bf16x8 v; unsigned u[4]; } cv;
#pragma unroll
        for (int e = 0; e < 4; ++e) cv.u[e] = pack2(sacc[8 * s + 2 * e], sacc[8 * s + 2 * e + 1]);
        const int kb = sjb + 16 * s + 4 * h;
#pragma unroll
        for (int dt = 0; dt < 2; ++dt) {
          union { bf16x8 v; uint2 u[2]; } va;
          va.u[0] = *(const uint2*)(Vt + (dt * 32 + r) * VT_STRIDE + kb);
          va.u[1] = *(const uint2*)(Vt + (dt * 32 + r) * VT_STRIDE + kb + 8);
          oacc[dt] = __builtin_amdgcn_mfma_f32_32x32x16_bf16(va.v, cv.v, oacc[dt], 0, 0, 0);
        }
      }
    }
    float inv = 1.f / lrun;
#pragma unroll
    for (int dt = 0; dt < 2; ++dt)
#pragma unroll
      for (int g4 = 0; g4 < 4; ++g4) {
        int d = dt * 32 + 8 * g4 + 4 * h;
        uint2 o;
        o.x = pack2(oacc[dt][4 * g4 + 0] * inv, oacc[dt][4 * g4 + 1] * inv);
        o.y = pack2(oacc[dt][4 * g4 + 2] * inv, oacc[dt][4 * g4 + 3] * inv);
        *(uint2*)(ao + tok * 512 + hq * 64 + d) = o;
      }
  }
}

__device__ __forceinline__ void attn_sample_item(const int tix, const Params& p, int item, unsigned char* smem) {
  const int b = item >> 1, kvh = item & 1;
  const u16* zq = (const u16*)(p.ws + OFF_ZQ);
  const u16* zk = (const u16*)(p.ws + OFF_ZK);
  const u16* zv = (const u16*)(p.ws + OFF_ZV);
  u16* ao = (u16*)(p.ws + OFF_AO);
  float* Kf = (float*)smem;
  float* Vf = Kf + 136 * 68;
  float* Qf = Vf + 136 * 64;
  float* Pf = Qf + 32 * 64;
  __syncthreads();
  for (int i = tix; i < 136 * 16; i += 512) {
    int j = i >> 4, d = (i & 15) * 4;
    float4 kv, vv;
    if (j < 128) {
      kv = *(const float4*)(p.cache_k + ((long)(b * 128 + j) * 2 + kvh) * 64 + d);
      vv = *(const float4*)(p.cache_v + ((long)(b * 128 + j) * 2 + kvh) * 64 + d);
    } else {
      long tok = (long)NP + b * 8 + (j - 128);
      uint2 kw = *(const uint2*)(zk + tok * 128 + kvh * 64 + d), vw = *(const uint2*)(zv + tok * 128 + kvh * 64 + d);
      kv = make_float4(__uint_as_float(kw.x << 16), __uint_as_float(kw.x & 0xffff0000u), __uint_as_float(kw.y << 16), __uint_as_float(kw.y & 0xffff0000u));
      vv = make_float4(__uint_as_float(vw.x << 16), __uint_as_float(vw.x & 0xffff0000u), __uint_as_float(vw.y << 16), __uint_as_float(vw.y & 0xffff0000u));
    }
    *(float4*)(Kf + j * 68 + d) = kv;
    *(float4*)(Vf + j * 64 + d) = vv;
  }
  for (int i = tix; i < 32 * 64; i += 512) {
    int rr = i >> 6, d = i & 63, hl = rr >> 3, s = rr & 7;
    long tok = (long)NP + b * 8 + s;
    Qf[i] = bf2f(zq[tok * 512 + (kvh * 4 + hl) * 64 + d]);
  }
  __syncthreads();
  const int rr = tix >> 4, tt = tix & 15, hl = rr >> 3, s = rr & 7;
  const float sink = p.sinks[kvh * 4 + hl];
  float mx = sink;
  for (int j = tt; j < 136; j += 16) {
    float acc = 0.f;
#pragma unroll
    for (int d = 0; d < 64; d += 4) {
      float4 q = *(const float4*)(Qf + rr * 64 + d), k = *(const float4*)(Kf + j * 68 + d);
      acc += q.x * k.x + q.y * k.y + q.z * k.z + q.w * k.w;
    }
    bool valid = (j > s) && (j <= s + 128);
    float sc = valid ? acc * 0.125f : -1.0e30f;
    Pf[rr * 136 + j] = sc;
    mx = fmaxf(mx, sc);
  }
  for (int o = 8; o >= 1; o >>= 1) mx = fmaxf(mx, __shfl_xor(mx, o));
  float ls = 0.f;
  for (int j = tt; j < 136; j += 16) {
    float e = __expf(Pf[rr * 136 + j] - mx);
    Pf[rr * 136 + j] = e;
    ls += e;
  }
  for (int o = 8; o >= 1; o >>= 1) ls += __shfl_xor(ls, o);
  float inv = 1.f / (ls + __expf(sink - mx));
  __syncthreads();
  float o4[4] = {0.f, 0.f, 0.f, 0.f};
  for (int j = 0; j < 136; ++j) {
    float pj = Pf[rr * 136 + j];
    float4 v = *(const float4*)(Vf + j * 64 + tt * 4);
    o4[0] += pj * v.x; o4[1] += pj * v.y; o4[2] += pj * v.z; o4[3] += pj * v.w;
  }
  long tok = (long)NP + b * 8 + s;
  uint2 o;
  o.x = pack2(o4[0] * inv, o4[1] * inv);
  o.y = pack2(o4[2] * inv, o4[3] * inv);
  *(uint2*)(ao + tok * 512 + (kvh * 4 + hl) * 64 + tt * 4) = o;
}

__device__ __forceinline__ void phase_ln1(const int tix, const Params& p) {
  const int wid = tix >> 6, lane = tix & 63;
  const u16* rx = (const u16*)(p.ws + OFF_RX);
  u16* x1b = (u16*)(p.ws + OFF_X1B);
  for (int row = blockIdx.x * 8 + wid; row < NT; row += gridDim.x * 8) {
    float4 v[4];
    float s = 0.f;
#pragma unroll
    for (int i = 0; i < 4; ++i) {
      const uint2 w_ = *(const uint2*)(rx + (long)row * 1024 + i * 256 + lane * 4);
      v[i] = make_float4(__uint_as_float(w_.x << 16), __uint_as_float(w_.x & 0xffff0000u), __uint_as_float(w_.y << 16), __uint_as_float(w_.y & 0xffff0000u));
      s += v[i].x + v[i].y + v[i].z + v[i].w;
    }
    float mu = wave_sum(s) * (1.f / 1024.f);
    float q = 0.f;
#pragma unroll
    for (int i = 0; i < 4; ++i) {
      float a = v[i].x - mu, b = v[i].y - mu, c = v[i].z - mu, d = v[i].w - mu;
      q += a * a + b * b + c * c + d * d;
    }
    float rstd = rsqrtf(wave_sum(q) * (1.f / 1024.f) + 1e-5f);
#pragma unroll
    for (int i = 0; i < 4; ++i) {
      int c = i * 256 + lane * 4;
      float4 g = *(const float4*)(p.ln1_g + c), bb = *(const float4*)(p.ln1_b + c);
      float4 o;
      o.x = (v[i].x - mu) * rstd * g.x + bb.x;
      o.y = (v[i].y - mu) * rstd * g.y + bb.y;
      o.z = (v[i].z - mu) * rstd * g.z + bb.z;
      o.w = (v[i].w - mu) * rstd * g.w + bb.w;
      uint2 ob;
      ob.x = pack2(o.x, o.y);
      ob.y = pack2(o.z, o.w);
      *(uint2*)(x1b + (long)row * 1024 + c) = ob;
    }
  }
}

__device__ __forceinline__ void phase_conv(const int tix, const Params& p, const int wk, const int nwk, const int part) {
  const long T = (long)nwk * 512;
  const long tid = (long)wk * 512 + tix;
  uint4* pu = (uint4*)(p.ws + OFF_PU);
  uint4* pv = (uint4*)(p.ws + OFF_PV);
  for (long i = (long)part * (8192L * 64) + tid; i < (long)(part + 1) * (8192L * 64); i += T) {
    uint4 oa, ob;
    unsigned* wa = (unsigned*)&oa;
    unsigned* wb = (unsigned*)&ob;
#pragma unroll
    for (int q = 0; q < 4; ++q) {
      float4 a = ldnt4((const float*)(p.peer_u + i * 16 + q * 4));
      float4 b = ldnt4((const float*)(p.peer_v + i * 16 + q * 4));
      int w = 0;
      w = __builtin_amdgcn_cvt_pk_fp8_f32(a.x * PU_SCALE, a.y * PU_SCALE, w, false);
      w = __builtin_amdgcn_cvt_pk_fp8_f32(a.z * PU_SCALE, a.w * PU_SCALE, w, true);
      wa[q] = (unsigned)w;
      w = 0;
      w = __builtin_amdgcn_cvt_pk_fp8_f32(b.x * PV_SCALE, b.y * PV_SCALE, w, false);
      w = __builtin_amdgcn_cvt_pk_fp8_f32(b.z * PV_SCALE, b.w * PV_SCALE, w, true);
      wb[q] = (unsigned)w;
    }
    pu[i] = oa;
    pv[i] = ob;
  }
}

__device__ __forceinline__ void sort16_desc(unsigned (&s)[16]) {
  { unsigned hi_ = max(s[0], s[1]), lo_ = min(s[0], s[1]); s[0] = hi_; s[1] = lo_; }
  { unsigned hi_ = max(s[2], s[3]), lo_ = min(s[2], s[3]); s[2] = lo_; s[3] = hi_; }
  { unsigned hi_ = max(s[4], s[5]), lo_ = min(s[4], s[5]); s[4] = hi_; s[5] = lo_; }
  { unsigned hi_ = max(s[6], s[7]), lo_ = min(s[6], s[7]); s[6] = lo_; s[7] = hi_; }
  { unsigned hi_ = max(s[8], s[9]), lo_ = min(s[8], s[9]); s[8] = hi_; s[9] = lo_; }
  { unsigned hi_ = max(s[10], s[11]), lo_ = min(s[10], s[11]); s[10] = lo_; s[11] = hi_; }
  { unsigned hi_ = max(s[12], s[13]), lo_ = min(s[12], s[13]); s[12] = hi_; s[13] = lo_; }
  { unsigned hi_ = max(s[14], s[15]), lo_ = min(s[14], s[15]); s[14] = lo_; s[15] = hi_; }
  { unsigned hi_ = max(s[0], s[2]), lo_ = min(s[0], s[2]); s[0] = hi_; s[2] = lo_; }
  { unsigned hi_ = max(s[1], s[3]), lo_ = min(s[1], s[3]); s[1] = hi_; s[3] = lo_; }
  { unsigned hi_ = max(s[4], s[6]), lo_ = min(s[4], s[6]); s[4] = lo_; s[6] = hi_; }
  { unsigned hi_ = max(s[5], s[7]), lo_ = min(s[5], s[7]); s[5] = lo_; s[7] = hi_; }
  { unsigned hi_ = max(s[8], s[10]), lo_ = min(s[8], s[10]); s[8] = hi_; s[10] = lo_; }
  { unsigned hi_ = max(s[9], s[11]), lo_ = min(s[9], s[11]); s[9] = hi_; s[11] = lo_; }
  { unsigned hi_ = max(s[12], s[14]), lo_ = min(s[12], s[14]); s[12] = lo_; s[14] = hi_; }
  { unsigned hi_ = max(s[13], s[15]), lo_ = min(s[13], s[15]); s[13] = lo_; s[15] = hi_; }
  { unsigned hi_ = max(s[0], s[1]), lo_ = min(s[0], s[1]); s[0] = hi_; s[1] = lo_; }
  { unsigned hi_ = max(s[2], s[3]), lo_ = min(s[2], s[3]); s[2] = hi_; s[3] = lo_; }
  { unsigned hi_ = max(s[4], s[5]), lo_ = min(s[4], s[5]); s[4] = lo_; s[5] = hi_; }
  { unsigned hi_ = max(s[6], s[7]), lo_ = min(s[6], s[7]); s[6] = lo_; s[7] = hi_; }
  { unsigned hi_ = max(s[8], s[9]), lo_ = min(s[8], s[9]); s[8] = hi_; s[9] = lo_; }
  { unsigned hi_ = max(s[10], s[11]), lo_ = min(s[10], s[11]); s[10] = hi_; s[11] = lo_; }
  { unsigned hi_ = max(s[12], s[13]), lo_ = min(s[12], s[13]); s[12] = lo_; s[13] = hi_; }
  { unsigned hi_ = max(s[14], s[15]), lo_ = min(s[14], s[15]); s[14] = lo_; s[15] = hi_; }
  { unsigned hi_ = max(s[0], s[4]), lo_ = min(s[0], s[4]); s[0] = hi_; s[4] = lo_; }
  { unsigned hi_ = max(s[1], s[5]), lo_ = min(s[1], s[5]); s[1] = hi_; s[5] = lo_; }
  { unsigned hi_ = max(s[2], s[6]), lo_ = min(s[2], s[6]); s[2] = hi_; s[6] = lo_; }
  { unsigned hi_ = max(s[3], s[7]), lo_ = min(s[3], s[7]); s[3] = hi_; s[7] = lo_; }
  { unsigned hi_ = max(s[8], s[12]), lo_ = min(s[8], s[12]); s[8] = lo_; s[12] = hi_; }
  { unsigned hi_ = max(s[9], s[13]), lo_ = min(s[9], s[13]); s[9] = lo_; s[13] = hi_; }
  { unsigned hi_ = max(s[10], s[14]), lo_ = min(s[10], s[14]); s[10] = lo_; s[14] = hi_; }
  { unsigned hi_ = max(s[11], s[15]), lo_ = min(s[11], s[15]); s[11] = lo_; s[15] = hi_; }
  { unsigned hi_ = max(s[0], s[2]), lo_ = min(s[0], s[2]); s[0] = hi_; s[2] = lo_; }
  { unsigned hi_ = max(s[1], s[3]), lo_ = min(s[1], s[3]); s[1] = hi_; s[3] = lo_; }
  { unsigned hi_ = max(s[4], s[6]), lo_ = min(s[4], s[6]); s[4] = hi_; s[6] = lo_; }
  { unsigned hi_ = max(s[5], s[7]), lo_ = min(s[5], s[7]); s[5] = hi_; s[7] = lo_; }
  { unsigned hi_ = max(s[8], s[10]), lo_ = min(s[8], s[10]); s[8] = lo_; s[10] = hi_; }
  { unsigned hi_ = max(s[9], s[11]), lo_ = min(s[9], s[11]); s[9] = lo_; s[11] = hi_; }
  { unsigned hi_ = max(s[12], s[14]), lo_ = min(s[12], s[14]); s[12] = lo_; s[14] = hi_; }
  { unsigned hi_ = max(s[13], s[15]), lo_ = min(s[13], s[15]); s[13] = lo_; s[15] = hi_; }
  { unsigned hi_ = max(s[0], s[1]), lo_ = min(s[0], s[1]); s[0] = hi_; s[1] = lo_; }
  { unsigned hi_ = max(s[2], s[3]), lo_ = min(s[2], s[3]); s[2] = hi_; s[3] = lo_; }
  { unsigned hi_ = max(s[4], s[5]), lo_ = min(s[4], s[5]); s[4] = hi_; s[5] = lo_; }
  { unsigned hi_ = max(s[6], s[7]), lo_ = min(s[6], s[7]); s[6] = hi_; s[7] = lo_; }
  { unsigned hi_ = max(s[8], s[9]), lo_ = min(s[8], s[9]); s[8] = lo_; s[9] = hi_; }
  { unsigned hi_ = max(s[10], s[11]), lo_ = min(s[10], s[11]); s[10] = lo_; s[11] = hi_; }
  { unsigned hi_ = max(s[12], s[13]), lo_ = min(s[12], s[13]); s[12] = lo_; s[13] = hi_; }
  { unsigned hi_ = max(s[14], s[15]), lo_ = min(s[14], s[15]); s[14] = lo_; s[15] = hi_; }
  { unsigned hi_ = max(s[0], s[8]), lo_ = min(s[0], s[8]); s[0] = hi_; s[8] = lo_; }
  { unsigned hi_ = max(s[1], s[9]), lo_ = min(s[1], s[9]); s[1] = hi_; s[9] = lo_; }
  { unsigned hi_ = max(s[2], s[10]), lo_ = min(s[2], s[10]); s[2] = hi_; s[10] = lo_; }
  { unsigned hi_ = max(s[3], s[11]), lo_ = min(s[3], s[11]); s[3] = hi_; s[11] = lo_; }
  { unsigned hi_ = max(s[4], s[12]), lo_ = min(s[4], s[12]); s[4] = hi_; s[12] = lo_; }
  { unsigned hi_ = max(s[5], s[13]), lo_ = min(s[5], s[13]); s[5] = hi_; s[13] = lo_; }
  { unsigned hi_ = max(s[6], s[14]), lo_ = min(s[6], s[14]); s[6] = hi_; s[14] = lo_; }
  { unsigned hi_ = max(s[7], s[15]), lo_ = min(s[7], s[15]); s[7] = hi_; s[15] = lo_; }
  { unsigned hi_ = max(s[0], s[4]), lo_ = min(s[0], s[4]); s[0] = hi_; s[4] = lo_; }
  { unsigned hi_ = max(s[1], s[5]), lo_ = min(s[1], s[5]); s[1] = hi_; s[5] = lo_; }
  { unsigned hi_ = max(s[2], s[6]), lo_ = min(s[2], s[6]); s[2] = hi_; s[6] = lo_; }
  { unsigned hi_ = max(s[3], s[7]), lo_ = min(s[3], s[7]); s[3] = hi_; s[7] = lo_; }
  { unsigned hi_ = max(s[8], s[12]), lo_ = min(s[8], s[12]); s[8] = hi_; s[12] = lo_; }
  { unsigned hi_ = max(s[9], s[13]), lo_ = min(s[9], s[13]); s[9] = hi_; s[13] = lo_; }
  { unsigned hi_ = max(s[10], s[14]), lo_ = min(s[10], s[14]); s[10] = hi_; s[14] = lo_; }
  { unsigned hi_ = max(s[11], s[15]), lo_ = min(s[11], s[15]); s[11] = hi_; s[15] = lo_; }
  { unsigned hi_ = max(s[0], s[2]), lo_ = min(s[0], s[2]); s[0] = hi_; s[2] = lo_; }
  { unsigned hi_ = max(s[1], s[3]), lo_ = min(s[1], s[3]); s[1] = hi_; s[3] = lo_; }
  { unsigned hi_ = max(s[4], s[6]), lo_ = min(s[4], s[6]); s[4] = hi_; s[6] = lo_; }
  { unsigned hi_ = max(s[5], s[7]), lo_ = min(s[5], s[7]); s[5] = hi_; s[7] = lo_; }
  { unsigned hi_ = max(s[8], s[10]), lo_ = min(s[8], s[10]); s[8] = hi_; s[10] = lo_; }
  { unsigned hi_ = max(s[9], s[11]), lo_ = min(s[9], s[11]); s[9] = hi_; s[11] = lo_; }
  { unsigned hi_ = max(s[12], s[14]), lo_ = min(s[12], s[14]); s[12] = hi_; s[14] = lo_; }
  { unsigned hi_ = max(s[13], s[15]), lo_ = min(s[13], s[15]); s[13] = hi_; s[15] = lo_; }
  { unsigned hi_ = max(s[0], s[1]), lo_ = min(s[0], s[1]); s[0] = hi_; s[1] = lo_; }
  { unsigned hi_ = max(s[2], s[3]), lo_ = min(s[2], s[3]); s[2] = hi_; s[3] = lo_; }
  { unsigned hi_ = max(s[4], s[5]), lo_ = min(s[4], s[5]); s[4] = hi_; s[5] = lo_; }
  { unsigned hi_ = max(s[6], s[7]), lo_ = min(s[6], s[7]); s[6] = hi_; s[7] = lo_; }
  { unsigned hi_ = max(s[8], s[9]), lo_ = min(s[8], s[9]); s[8] = hi_; s[9] = lo_; }
  { unsigned hi_ = max(s[10], s[11]), lo_ = min(s[10], s[11]); s[10] = hi_; s[11] = lo_; }
  { unsigned hi_ = max(s[12], s[13]), lo_ = min(s[12], s[13]); s[12] = hi_; s[13] = lo_; }
  { unsigned hi_ = max(s[14], s[15]), lo_ = min(s[14], s[15]); s[14] = hi_; s[15] = lo_; }
}
__device__ __forceinline__ void merge16_desc(unsigned (&t)[16], const unsigned (&s)[16]) {
#pragma unroll
  for (int i = 0; i < 16; ++i) t[i] = max(t[i], s[15 - i]);
  { unsigned hi_ = max(t[0], t[8]), lo_ = min(t[0], t[8]); t[0] = hi_; t[8] = lo_; }
  { unsigned hi_ = max(t[1], t[9]), lo_ = min(t[1], t[9]); t[1] = hi_; t[9] = lo_; }
  { unsigned hi_ = max(t[2], t[10]), lo_ = min(t[2], t[10]); t[2] = hi_; t[10] = lo_; }
  { unsigned hi_ = max(t[3], t[11]), lo_ = min(t[3], t[11]); t[3] = hi_; t[11] = lo_; }
  { unsigned hi_ = max(t[4], t[12]), lo_ = min(t[4], t[12]); t[4] = hi_; t[12] = lo_; }
  { unsigned hi_ = max(t[5], t[13]), lo_ = min(t[5], t[13]); t[5] = hi_; t[13] = lo_; }
  { unsigned hi_ = max(t[6], t[14]), lo_ = min(t[6], t[14]); t[6] = hi_; t[14] = lo_; }
  { unsigned hi_ = max(t[7], t[15]), lo_ = min(t[7], t[15]); t[7] = hi_; t[15] = lo_; }
  { unsigned hi_ = max(t[0], t[4]), lo_ = min(t[0], t[4]); t[0] = hi_; t[4] = lo_; }
  { unsigned hi_ = max(t[1], t[5]), lo_ = min(t[1], t[5]); t[1] = hi_; t[5] = lo_; }
  { unsigned hi_ = max(t[2], t[6]), lo_ = min(t[2], t[6]); t[2] = hi_; t[6] = lo_; }
  { unsigned hi_ = max(t[3], t[7]), lo_ = min(t[3], t[7]); t[3] = hi_; t[7] = lo_; }
  { unsigned hi_ = max(t[8], t[12]), lo_ = min(t[8], t[12]); t[8] = hi_; t[12] = lo_; }
  { unsigned hi_ = max(t[9], t[13]), lo_ = min(t[9], t[13]); t[9] = hi_; t[13] = lo_; }
  { unsigned hi_ = max(t[10], t[14]), lo_ = min(t[10], t[14]); t[10] = hi_; t[14] = lo_; }
  { unsigned hi_ = max(t[11], t[15]), lo_ = min(t[11], t[15]); t[11] = hi_; t[15] = lo_; }
  { unsigned hi_ = max(t[0], t[2]), lo_ = min(t[0], t[2]); t[0] = hi_; t[2] = lo_; }
  { unsigned hi_ = max(t[1], t[3]), lo_ = min(t[1], t[3]); t[1] = hi_; t[3] = lo_; }
  { unsigned hi_ = max(t[4], t[6]), lo_ = min(t[4], t[6]); t[4] = hi_; t[6] = lo_; }
  { unsigned hi_ = max(t[5], t[7]), lo_ = min(t[5], t[7]); t[5] = hi_; t[7] = lo_; }
  { unsigned hi_ = max(t[8], t[10]), lo_ = min(t[8], t[10]); t[8] = hi_; t[10] = lo_; }
  { unsigned hi_ = max(t[9], t[11]), lo_ = min(t[9], t[11]); t[9] = hi_; t[11] = lo_; }
  { unsigned hi_ = max(t[12], t[14]), lo_ = min(t[12], t[14]); t[12] = hi_; t[14] = lo_; }
  { unsigned hi_ = max(t[13], t[15]), lo_ = min(t[13], t[15]); t[13] = hi_; t[15] = lo_; }
  { unsigned hi_ = max(t[0], t[1]), lo_ = min(t[0], t[1]); t[0] = hi_; t[1] = lo_; }
  { unsigned hi_ = max(t[2], t[3]), lo_ = min(t[2], t[3]); t[2] = hi_; t[3] = lo_; }
  { unsigned hi_ = max(t[4], t[5]), lo_ = min(t[4], t[5]); t[4] = hi_; t[5] = lo_; }
  { unsigned hi_ = max(t[6], t[7]), lo_ = min(t[6], t[7]); t[6] = hi_; t[7] = lo_; }
  { unsigned hi_ = max(t[8], t[9]), lo_ = min(t[8], t[9]); t[8] = hi_; t[9] = lo_; }
  { unsigned hi_ = max(t[10], t[11]), lo_ = min(t[10], t[11]); t[10] = hi_; t[11] = lo_; }
  { unsigned hi_ = max(t[12], t[13]), lo_ = min(t[12], t[13]); t[12] = hi_; t[13] = lo_; }
  { unsigned hi_ = max(t[14], t[15]), lo_ = min(t[14], t[15]); t[14] = hi_; t[15] = lo_; }
}
__device__ __forceinline__ void topk_insert(const unsigned short* sc, unsigned* t_out) {
  unsigned t[16], s[16];
  uint4 c0 = *(const uint4*)sc, c1 = *(const uint4*)(sc + 8), n0 = c0, n1 = c1;
#pragma unroll 1
  for (int c = 0; c < 8; ++c) {
    if (c + 1 < 8) { n0 = *(const uint4*)(sc + (c + 1) * 16); n1 = *(const uint4*)(sc + (c + 1) * 16 + 8); }
    const unsigned w[8] = {c0.x, c0.y, c0.z, c0.w, c1.x, c1.y, c1.z, c1.w};
#pragma unroll
    for (int e = 0; e < 16; ++e) {
      const unsigned ww = w[e >> 1];
      const unsigned h = (e & 1) ? (ww >> 16) : (ww & 0xffffu);
      const int m = (e & 1) ? ((int)ww >> 31) : ((int)(ww << 16) >> 31);
      const unsigned key = h ^ (0x8000u | ((unsigned)m & 0x7fffu));
      s[e] = (key << 16) | (unsigned)(127 - (c * 16 + e));
    }
    sort16_desc(s);
    if (c == 0) {
#pragma unroll
      for (int i = 0; i < 16; ++i) t[i] = s[i];
    } else {
      merge16_desc(t, s);
    }
    c0 = n0; c1 = n1;
  }
#pragma unroll
  for (int i = 0; i < 16; ++i) t_out[i] = t[i];
}
__device__ __forceinline__ float key_to_f32(unsigned t) {
  unsigned key = t >> 16;
  unsigned h = (key & 0x8000u) ? (key ^ 0x8000u) : (key ^ 0xffffu);
  return (float)__builtin_bit_cast(_Float16, (unsigned short)h);
}

template <int LV>
__device__ __forceinline__ void cand_insert(float vc, float (&tv)[16]) {
#pragma unroll
  for (int k = 0; k < LV; ++k) {
    const float hi = fmaxf(tv[k], vc);
    vc = fminf(tv[k], vc);
    tv[k] = hi;
  }
}

__device__ __forceinline__ void phase_peer(const int tix, const Params& p, unsigned char* smem) {
  const int wid = tix >> 6, lane = tix & 63;
  int* sidx_all = (int*)smem;
  float* sgate_all = (float*)(smem + 34816);
  int* cnt = (int*)(smem + 69632);
  float* sh_all = (float*)(smem + 69632 + 64);
  const unsigned short* SC = (const unsigned short*)(p.ws + OFF_SC);
  const u16* X1B = (const u16*)(p.ws + OFF_X1B);
  const unsigned char* PU = (const unsigned char*)(p.ws + OFF_PU);
  const unsigned char* PV = (const unsigned char*)(p.ws + OFF_PV);
  for (int blk = blockIdx.x; blk < 256; blk += gridDim.x) {
   const int tok0 = blk * 68;
   __syncthreads();
   if (tix == 0) { cnt[0] = 64; cnt[1] = 0; }
   __syncthreads();
#pragma unroll 1
   for (int pass = (wid == 0 ? 0 : 1); pass < 2; ++pass) {
    const int rowbase = pass == 0 ? 512 : wid * 64;
    const int row = rowbase + lane;
    const bool act = row < 544;
    const int rr = act ? row : 0, tl = rr >> 3, hh = rr & 7;
    const unsigned short* sc = SC + (long)(tok0 + tl) * 2048 + hh * 256;
    unsigned t1[16], t2[16];
    topk_insert(sc, t1);
    topk_insert(sc + 128, t2);
    float f1[16], f2[16];
#pragma unroll
    for (int k = 0; k < 16; ++k) { f1[k] = key_to_f32(t1[k]); f2[k] = key_to_f32(t2[k]); }
    int id1[16], id2[16];
#pragma unroll
    for (int k = 0; k < 16; ++k) { id1[k] = (127 - (int)(t1[k] & 0x7fu)) * 128; id2[k] = 127 - (int)(t2[k] & 0x7fu); }
    float tv[16];
#pragma unroll
    for (int k = 0; k < 16; ++k) tv[k] = -INFINITY;
    cand_insert<1>(f1[0] + f2[0], tv);
    cand_insert<2>(f1[0] + f2[1], tv);
    cand_insert<3>(f1[0] + f2[2], tv);
    cand_insert<4>(f1[0] + f2[3], tv);
    cand_insert<5>(f1[0] + f2[4], tv);
    cand_insert<6>(f1[0] + f2[5], tv);
    cand_insert<7>(f1[0] + f2[6], tv);
    cand_insert<8>(f1[0] + f2[7], tv);
    cand_insert<9>(f1[0] + f2[8], tv);
    cand_insert<10>(f1[0] + f2[9], tv);
    cand_insert<11>(f1[0] + f2[10], tv);
    cand_insert<12>(f1[0] + f2[11], tv);
    cand_insert<13>(f1[0] + f2[12], tv);
    cand_insert<14>(f1[0] + f2[13], tv);
    cand_insert<15>(f1[0] + f2[14], tv);
    cand_insert<16>(f1[0] + f2[15], tv);
    cand_insert<16>(f1[1] + f2[0], tv);
    cand_insert<16>(f1[1] + f2[1], tv);
    cand_insert<16>(f1[1] + f2[2], tv);
    cand_insert<16>(f1[1] + f2[3], tv);
    cand_insert<16>(f1[1] + f2[4], tv);
    cand_insert<16>(f1[1] + f2[5], tv);
    cand_insert<16>(f1[1] + f2[6], tv);
    cand_insert<16>(f1[1] + f2[7], tv);
    cand_insert<16>(f1[2] + f2[0], tv);
    cand_insert<16>(f1[2] + f2[1], tv);
    cand_insert<16>(f1[2] + f2[2], tv);
    cand_insert<16>(f1[2] + f2[3], tv);
    cand_insert<16>(f1[2] + f2[4], tv);
    cand_insert<16>(f1[3] + f2[0], tv);
    cand_insert<16>(f1[3] + f2[1], tv);
    cand_insert<16>(f1[3] + f2[2], tv);
    cand_insert<16>(f1[3] + f2[3], tv);
    cand_insert<16>(f1[4] + f2[0], tv);
    cand_insert<16>(f1[4] + f2[1], tv);
    cand_insert<16>(f1[4] + f2[2], tv);
    cand_insert<16>(f1[5] + f2[0], tv);
    cand_insert<16>(f1[5] + f2[1], tv);
    cand_insert<16>(f1[6] + f2[0], tv);
    cand_insert<16>(f1[6] + f2[1], tv);
    cand_insert<16>(f1[7] + f2[0], tv);
    cand_insert<16>(f1[7] + f2[1], tv);
    cand_insert<16>(f1[8] + f2[0], tv);
    cand_insert<16>(f1[9] + f2[0], tv);
    cand_insert<16>(f1[10] + f2[0], tv);
    cand_insert<16>(f1[11] + f2[0], tv);
    cand_insert<16>(f1[12] + f2[0], tv);
    cand_insert<16>(f1[13] + f2[0], tv);
    cand_insert<16>(f1[14] + f2[0], tv);
    cand_insert<16>(f1[15] + f2[0], tv);
    float den = 0.f;
#pragma unroll
    for (int k = 0; k < 16; ++k) den += __expf(tv[k] - tv[0]);
    const float inv = 1.f / den, T = tv[15], top = tv[0];
    int ngt = 0;
    ngt += (f1[0] + f2[0] > T) ? 1 : 0;
    ngt += (f1[0] + f2[1] > T) ? 1 : 0;
    ngt += (f1[0] + f2[2] > T) ? 1 : 0;
    ngt += (f1[0] + f2[3] > T) ? 1 : 0;
    ngt += (f1[0] + f2[4] > T) ? 1 : 0;
    ngt += (f1[0] + f2[5] > T) ? 1 : 0;
    ngt += (f1[0] + f2[6] > T) ? 1 : 0;
    ngt += (f1[0] + f2[7] > T) ? 1 : 0;
    ngt += (f1[0] + f2[8] > T) ? 1 : 0;
    ngt += (f1[0] + f2[9] > T) ? 1 : 0;
    ngt += (f1[0] + f2[10] > T) ? 1 : 0;
    ngt += (f1[0] + f2[11] > T) ? 1 : 0;
    ngt += (f1[0] + f2[12] > T) ? 1 : 0;
    ngt += (f1[0] + f2[13] > T) ? 1 : 0;
    ngt += (f1[0] + f2[14] > T) ? 1 : 0;
    ngt += (f1[0] + f2[15] > T) ? 1 : 0;
    ngt += (f1[1] + f2[0] > T) ? 1 : 0;
    ngt += (f1[1] + f2[1] > T) ? 1 : 0;
    ngt += (f1[1] + f2[2] > T) ? 1 : 0;
    ngt += (f1[1] + f2[3] > T) ? 1 : 0;
    ngt += (f1[1] + f2[4] > T) ? 1 : 0;
    ngt += (f1[1] + f2[5] > T) ? 1 : 0;
    ngt += (f1[1] + f2[6] > T) ? 1 : 0;
    ngt += (f1[1] + f2[7] > T) ? 1 : 0;
    ngt += (f1[2] + f2[0] > T) ? 1 : 0;
    ngt += (f1[2] + f2[1] > T) ? 1 : 0;
    ngt += (f1[2] + f2[2] > T) ? 1 : 0;
    ngt += (f1[2] + f2[3] > T) ? 1 : 0;
    ngt += (f1[2] + f2[4] > T) ? 1 : 0;
    ngt += (f1[3] + f2[0] > T) ? 1 : 0;
    ngt += (f1[3] + f2[1] > T) ? 1 : 0;
    ngt += (f1[3] + f2[2] > T) ? 1 : 0;
    ngt += (f1[3] + f2[3] > T) ? 1 : 0;
    ngt += (f1[4] + f2[0] > T) ? 1 : 0;
    ngt += (f1[4] + f2[1] > T) ? 1 : 0;
    ngt += (f1[4] + f2[2] > T) ? 1 : 0;
    ngt += (f1[5] + f2[0] > T) ? 1 : 0;
    ngt += (f1[5] + f2[1] > T) ? 1 : 0;
    ngt += (f1[6] + f2[0] > T) ? 1 : 0;
    ngt += (f1[6] + f2[1] > T) ? 1 : 0;
    ngt += (f1[7] + f2[0] > T) ? 1 : 0;
    ngt += (f1[7] + f2[1] > T) ? 1 : 0;
    ngt += (f1[8] + f2[0] > T) ? 1 : 0;
    ngt += (f1[9] + f2[0] > T) ? 1 : 0;
    ngt += (f1[10] + f2[0] > T) ? 1 : 0;
    ngt += (f1[11] + f2[0] > T) ? 1 : 0;
    ngt += (f1[12] + f2[0] > T) ? 1 : 0;
    ngt += (f1[13] + f2[0] > T) ? 1 : 0;
    ngt += (f1[14] + f2[0] > T) ? 1 : 0;
    ngt += (f1[15] + f2[0] > T) ? 1 : 0;
    int need = 16 - ngt, pos = 0;
    int* so = sidx_all + tl * 128 + hh * 16;
    float* go = sgate_all + tl * 128 + hh * 16;
#define CAND_EMIT(I, J)                                                        \
    {                                                                          \
      const float vc = f1[I] + f2[J];                                          \
      const bool eq = (vc == T) && (need > 0);                                 \
      const bool sel = (vc > T) || eq;                                         \
      need -= eq ? 1 : 0;                                                      \
      if (sel && act) { so[pos] = id1[I] + id2[J]; go[pos] = __expf(vc - top) * inv; } \
      pos += sel ? 1 : 0;                                                      \
    }
    CAND_EMIT(0, 0)
    CAND_EMIT(0, 1)
    CAND_EMIT(0, 2)
    CAND_EMIT(0, 3)
    CAND_EMIT(0, 4)
    CAND_EMIT(0, 5)
    CAND_EMIT(0, 6)
    CAND_EMIT(0, 7)
    CAND_EMIT(0, 8)
    CAND_EMIT(0, 9)
    CAND_EMIT(0, 10)
    CAND_EMIT(0, 11)
    CAND_EMIT(0, 12)
    CAND_EMIT(0, 13)
    CAND_EMIT(0, 14)
    CAND_EMIT(0, 15)
    CAND_EMIT(1, 0)
    CAND_EMIT(1, 1)
    CAND_EMIT(1, 2)
    CAND_EMIT(1, 3)
    CAND_EMIT(1, 4)
    CAND_EMIT(1, 5)
    CAND_EMIT(1, 6)
    CAND_EMIT(1, 7)
    CAND_EMIT(2, 0)
    CAND_EMIT(2, 1)
    CAND_EMIT(2, 2)
    CAND_EMIT(2, 3)
    CAND_EMIT(2, 4)
    CAND_EMIT(3, 0)
    CAND_EMIT(3, 1)
    CAND_EMIT(3, 2)
    CAND_EMIT(3, 3)
    CAND_EMIT(4, 0)
    CAND_EMIT(4, 1)
    CAND_EMIT(4, 2)
    CAND_EMIT(5, 0)
    CAND_EMIT(5, 1)
    CAND_EMIT(6, 0)
    CAND_EMIT(6, 1)
    CAND_EMIT(7, 0)
    CAND_EMIT(7, 1)
    CAND_EMIT(8, 0)
    CAND_EMIT(9, 0)
    CAND_EMIT(10, 0)
    CAND_EMIT(11, 0)
    CAND_EMIT(12, 0)
    CAND_EMIT(13, 0)
    CAND_EMIT(14, 0)
    CAND_EMIT(15, 0)
#undef CAND_EMIT
    if (pass == 0) {
      asm volatile("s_waitcnt lgkmcnt(0)" ::: "memory");
      if (lane == 0) __hip_atomic_store(&cnt[1], 1, __ATOMIC_RELAXED, __HIP_MEMORY_SCOPE_WORKGROUP);
    }
   }
#pragma unroll 1
   for (int it = 0;; ++it) {
    int tl = wid * 8 + (it & 7);
    int mode = it < 16 ? 1 : 2;
    int cp_lo = it >> 3, cp_hi = it >> 3;
    if (it >= 24) {
      mode = 3; cp_lo = 0; cp_hi = 1;
      tl = 0;
      if (lane == 0) tl = atomicAdd(cnt, 1);
      tl = __builtin_amdgcn_readfirstlane(tl);
      if (tl >= 68) break;
      while (__hip_atomic_load(&cnt[1], __ATOMIC_RELAXED, __HIP_MEMORY_SCOPE_WORKGROUP) == 0) __builtin_amdgcn_s_sleep(1);
    }
    const int tok = tok0 + tl;
    int* sidx = sidx_all + tl * 128;
    float* sgate = sgate_all + tl * 128;
    f32x2 x2[8];
    {
      const uint4* xb_ = (const uint4*)(X1B + (long)tok * 1024 + lane * 16);
      uint4 w0 = xb_[0], w1 = xb_[1];
      unsigned w[8] = {w0.x, w0.y, w0.z, w0.w, w1.x, w1.y, w1.z, w1.w};
#pragma unroll
      for (int i = 0; i < 8; ++i) x2[i] = (f32x2){__uint_as_float(w[i] << 16), __uint_as_float(w[i] & 0xffff0000u)};
    }
    float hv0 = 0.f, hv1 = 0.f;
    uint4 ba[8], bb[8];
#define PLOAD(BUF, TAB, e0)                                                                   \
  _Pragma("unroll") for (int u = 0; u < 8; ++u)                                              \
      BUF[u] = *(const uint4*)(TAB + (long)sidx[(e0) + u] * 1024 + lane * 16);
#define PDOT(BUF, e0)                                                                         \
  _Pragma("unroll") for (int u = 0; u < 8; ++u) {                                            \
    unsigned w[4] = {BUF[u].x, BUF[u].y, BUF[u].z, BUF[u].w};                                 \
    f32x2 s2 = {0.f, 0.f};                                                                    \
    _Pragma("unroll") for (int kk = 0; kk < 4; ++kk) {                                        \
      f32x2 lo = __builtin_amdgcn_cvt_pk_f32_fp8((int)w[kk], false);                          \
      f32x2 hi = __builtin_amdgcn_cvt_pk_f32_fp8((int)w[kk], true);                           \
      s2 += lo * x2[kk * 2];                                                                  \
      s2 += hi * x2[kk * 2 + 1];                                                              \
    }                                                                                         \
    float tot = wsum(s2[0] + s2[1]);                                                          \
    int ee = (e0) + u;                                                                        \
    if (lane == (ee & 63)) { if (ee < 64) hv0 = tot; else hv1 = tot; }                        \
  }
#define PAXPY(BUF, e0)                                                                        \
  _Pragma("unroll") for (int u = 0; u < 8; ++u) {                                            \
    float a = sgate[(e0) + u];                                                                \
    f32x2 a2 = {a, a};                                                                        \
    unsigned w[4] = {BUF[u].x, BUF[u].y, BUF[u].z, BUF[u].w};                                 \
    _Pragma("unroll") for (int kk = 0; kk < 4; ++kk) {                                        \
      f32x2 lo = __builtin_amdgcn_cvt_pk_f32_fp8((int)w[kk], false);                          \
      f32x2 hi = __builtin_amdgcn_cvt_pk_f32_fp8((int)w[kk], true);                           \
      o2[kk * 2] += a2 * lo;                                                                  \
      o2[kk * 2 + 1] += a2 * hi;                                                              \
    }                                                                                         \
  }
    if (mode & 1) {
      float* sh = sh_all + tl * 128;
#pragma unroll 1
      for (int cp = cp_lo; cp <= cp_hi; ++cp) {
        const int colb = cp * 512 + (lane & 31) * 16;
        f32x2 xh[8];
        {
          const uint4* xb_ = (const uint4*)(X1B + (long)tok * 1024 + colb);
          uint4 w0 = xb_[0], w1 = xb_[1];
          unsigned w[8] = {w0.x, w0.y, w0.z, w0.w, w1.x, w1.y, w1.z, w1.w};
#pragma unroll
          for (int i = 0; i < 8; ++i) xh[i] = (f32x2){__uint_as_float(w[i] << 16), __uint_as_float(w[i] & 0xffff0000u)};
        }
#define PLOADU(BUF, e0)                                                                       \
  _Pragma("unroll") for (int u = 0; u < 8; ++u)                                              \
      BUF[u] = *(const uint4*)(PU + (long)sidx[(e0) + 2 * u + (lane >> 5)] * 1024 + colb);
#define PDOTU(BUF, e0)                                                                        \
  _Pragma("unroll") for (int u = 0; u < 8; ++u) {                                            \
    unsigned w[4] = {BUF[u].x, BUF[u].y, BUF[u].z, BUF[u].w};                                 \
    f32x2 s2 = {0.f, 0.f};                                                                    \
    _Pragma("unroll") for (int kk = 0; kk < 4; ++kk) {                                        \
      f32x2 lo = __builtin_amdgcn_cvt_pk_f32_fp8((int)w[kk], false);                          \
      f32x2 hi = __builtin_amdgcn_cvt_pk_f32_fp8((int)w[kk], true);                           \
      s2 += lo * xh[kk * 2];                                                                  \
      s2 += hi * xh[kk * 2 + 1];                                                              \
    }                                                                                         \
    const float v_ = row_sum16(s2[0] + s2[1]);                                                \
    float ta_ = rlane(v_, 0) + rlane(v_, 16), tb_ = rlane(v_, 32) + rlane(v_, 48);            \
    if (lane == 0) {                                                                          \
      if (cp) { ta_ += sh[(e0) + 2 * u]; tb_ += sh[(e0) + 2 * u + 1]; }                       \
      sh[(e0) + 2 * u] = ta_; sh[(e0) + 2 * u + 1] = tb_;                                     \
    }                                                                                         \
  }
        PLOADU(ba, 0)
#pragma unroll 1
        for (int e = 0; e < 128; e += 32) {
          PLOADU(bb, e + 16)
          PDOTU(ba, e)
          if (e + 32 < 128) { PLOADU(ba, e + 32) }
          PDOTU(bb, e + 16)
        }
#undef PLOADU
#undef PDOTU
      }
      if (cp_hi == 1) {
        float g0 = sgate[lane], g1 = sgate[lane + 64];
        sgate[lane] = gelu_(sh[lane] * (1.f / PU_SCALE)) * g0 * (1.f / PV_SCALE);
        sgate[lane + 64] = gelu_(sh[lane + 64] * (1.f / PU_SCALE)) * g1 * (1.f / PV_SCALE);
      }
    }
    if (!(mode & 2)) continue;
    f32x2 o2[8];
#pragma unroll
    for (int i = 0; i < 8; ++i) o2[i] = (f32x2){0.f, 0.f};
    PLOAD(ba, PV, 0)
#pragma unroll 1
    for (int e = 0; e < 128; e += 16) {
      PLOAD(bb, PV, e + 8)
      PAXPY(ba, e)
      if (e + 16 < 128) { PLOAD(ba, PV, e + 16) }
      PAXPY(bb, e + 8)
    }
#undef PLOAD
#undef PDOT
#undef PAXPY
    float o[16];
    float s = 0.f;
#pragma unroll
    for (int i = 0; i < 8; ++i) {
      o[2 * i] = ALPHA * x2[i][0] + o2[i][0];
      o[2 * i + 1] = ALPHA * x2[i][1] + o2[i][1];
      s += o[2 * i] + o[2 * i + 1];
    }
    float mu = wsum(s) * (1.f / 1024.f);
    float q = 0.f;
#pragma unroll
    for (int i = 0; i < 16; ++i) { float dd = o[i] - mu; q += dd * dd; }
    float rstd = rsqrtf(wsum(q) * (1.f / 1024.f) + 1e-5f);
#pragma unroll
    for (int i = 0; i < 4; ++i) {
      int cc = lane * 16 + i * 4;
      float4 g = *(const float4*)(p.ln2_g + cc), bb = *(const float4*)(p.ln2_b + cc);
      float4 y;
      y.x = (o[i * 4] - mu) * rstd * g.x + bb.x;
      y.y = (o[i * 4 + 1] - mu) * rstd * g.y + bb.y;
      y.z = (o[i * 4 + 2] - mu) * rstd * g.z + bb.z;
      y.w = (o[i * 4 + 3] - mu) * rstd * g.w + bb.w;
      __builtin_nontemporal_store(y.x, p.out + O_Y + (long)tok * 1024 + cc);
      __builtin_nontemporal_store(y.y, p.out + O_Y + (long)tok * 1024 + cc + 1);
      __builtin_nontemporal_store(y.z, p.out + O_Y + (long)tok * 1024 + cc + 2);
      __builtin_nontemporal_store(y.w, p.out + O_Y + (long)tok * 1024 + cc + 3);
    }
   }
  }
}

__device__ __forceinline__ Params load_params() {
  Params r;
#if defined(__HIP_DEVICE_COMPILE__)
  typedef const __attribute__((address_space(4))) unsigned long long* KP;
  KP k = (KP)__builtin_amdgcn_kernarg_segment_ptr();
  asm volatile("" : "+s"(k));
  unsigned long long* d = (unsigned long long*)&r;
#pragma unroll
  for (int i = 0; i < (int)(sizeof(Params) / 8); ++i) d[i] = k[i];
#endif
  return r;
}

__device__ __forceinline__ int make_tid(int wave_s) {
  int l;
  asm volatile("v_mbcnt_lo_u32_b32 %0, -1, 0\n\tv_mbcnt_hi_u32_b32 %0, -1, %0" : "=v"(l));
  return wave_s * 64 + l;
}

__global__ void __launch_bounds__(512) mega(Params p_unused, int ph_lo, int ph_hi) {
  extern __shared__ __attribute__((aligned(16))) unsigned char smem[];
  cg::grid_group grid = cg::this_grid();
  __shared__ uint4 xb_words;
  volatile LAS unsigned* xb_st = (volatile LAS unsigned*)&xb_words;
  if (threadIdx.x == 0) {
    xb_words = make_uint4(0u, 0u, 0u, 0u);
    const Params p0 = load_params();
    (void)xb_add(&((unsigned*)(p0.ws + WS_END))[XB_XCNT(xb_xcc_id())], 1u);
  }
  __syncthreads();
  if (ph_hi > 1000) grid.sync();
  const int wave_s = __builtin_amdgcn_readfirstlane((int)threadIdx.x >> 6);

#define PHASE(k, ...)                                                                     \
  if (ph_lo <= (k) && (k) < ph_hi) {                                                      \
    const Params p = load_params();                                                       \
    const int tix = make_tid(wave_s);                                                     \
    unsigned char* ws = p.ws;                                                             \
    { __VA_ARGS__ }                                                                       \
    if ((k) == REP) { __syncthreads(); { __VA_ARGS__ } }                                  \
    if ((k) + 1 < ph_hi) { gbar(tix, (unsigned*)(ws + WS_END), xb_st); } \
  }
#define PHASE_NB(k, ...)                                                                  \
  if (ph_lo <= (k) && (k) < ph_hi) {                                                      \
    const Params p = load_params();                                                       \
    const int tix = make_tid(wave_s);                                                     \
    unsigned char* ws = p.ws;                                                             \
    (void)ws;                                                                             \
    { __VA_ARGS__ }                                                                       \
  }
  PHASE(0, phase_prep(tix, p, smem, 0, blockIdx.x, gridDim.x);)
  PHASE_NB(1, EpiIn e{p.b_in, ws, p.out};
           gemm_phase(tix, (const u16*)(ws + OFF_XB), (const u16*)(ws + OFF_WIN), NT, 3328, 1024, e, smem);)
  PHASE(1, { const int rem = 884 % (int)gridDim.x;
             if (rem == 0) phase_prep(tix, p, smem, 1, blockIdx.x, gridDim.x);
             else if ((int)blockIdx.x >= rem) phase_prep(tix, p, smem, 1, blockIdx.x - rem, gridDim.x - rem); })
  PHASE(2, for (int it = blockIdx.x; it < 256 + 256 + 256; it += gridDim.x) {
             if (it < 256) attn_prompt_item(tix, p, it, smem);
             else if (it < 512) attn_sample_item(tix, p, it - 256, smem);
             else s5a_item(tix, p, it - 512);
           })
  PHASE_NB(3, EpiUp e{(const u16*)(ws + OFF_GA), (u16*)(ws + OFF_MS)};
           gemm_phase(tix, (const u16*)(ws + OFF_AO), (const u16*)(ws + OFF_WUP), NT, 1024, 512, e, smem);)
  PHASE(3, phase_carry(tix, p);)
  PHASE(4, for (int it = blockIdx.x; it < 256; it += gridDim.x) s5c_item(tix, p, it, smem);)
  PHASE(5, EpiGlu e{p.b_glu, (const u16*)(ws + OFF_MS), (u16*)(ws + OFF_GS)};
           gemm_phase(tix, (const u16*)(ws + OFF_HG), (const u16*)(ws + OFF_WGLU), NT, 2048, 512, e, smem);
           { const int rem = 544 % (int)gridDim.x;
             if (rem == 0) phase_conv(tix, p, blockIdx.x, gridDim.x, 0);
             else if ((int)blockIdx.x >= rem) phase_conv(tix, p, blockIdx.x - rem, gridDim.x - rem, 0); })
  PHASE(6, EpiOut e{p.x_prompt, p.x_sample, (u16*)(ws + OFF_RX)};
           gemm_phase(tix, (const u16*)(ws + OFF_MERGED), (const u16*)(ws + OFF_WOUT), NT, 1024, 1024, e, smem);
           { const int rem = 272 % (int)gridDim.x;
             if (rem == 0) phase_conv(tix, p, blockIdx.x, gridDim.x, 1);
             else if ((int)blockIdx.x >= rem) phase_conv(tix, p, blockIdx.x - rem, gridDim.x - rem, 1); })
  PHASE(7, phase_ln1(tix, p);)
  PHASE(8, EpiSc e{(_Float16*)(ws + OFF_SC)};
           gemm_phase(tix, (const u16*)(ws + OFF_X1B), (const u16*)(ws + OFF_WPQ), NT, 2048, 1024, e, smem);
           )
  PHASE(9, phase_peer(tix, p, smem);)
}

extern "C" void kernel_launch(void* const* d_in, const int* in_sizes, int n_in, void* d_out, int out_size, void* d_ws,
                              size_t ws_size, hipStream_t stream) {
  static int grid = 0;
  if (grid == 0) {
    if (n_in != 30 || ws_size < WS_END + XCD_BAR_WORDS * 4) {
      fprintf(stderr, "kernel_launch: need 30 inputs and %zu ws bytes; got %d, %zu\n", (size_t)WS_END, n_in, ws_size);
      grid = -1;
      return;
    }
    int dev = 0, cus = 0, per_cu = 0;
    hipGetDevice(&dev);
    hipDeviceGetAttribute(&cus, hipDeviceAttributeMultiprocessorCount, dev);
    if (hipFuncSetAttribute((const void*)mega, hipFuncAttributeMaxDynamicSharedMemorySize, LDS_BYTES) != hipSuccess) {
      fprintf(stderr, "kernel_launch: hipFuncSetAttribute failed\n");
      grid = -1;
      return;
    }
    hipOccupancyMaxActiveBlocksPerMultiprocessor(&per_cu, (const void*)mega, 512, LDS_BYTES);
    if (per_cu < 1) { fprintf(stderr, "kernel_launch: occupancy query says %d\n", per_cu); per_cu = 1; }
    (void)hipGetLastError();
    grid = cus;
  }
  if (grid < 0) return;
  Params p{};
  void** pp = (void**)&p;
  for (int i = 0; i < 30; ++i) pp[i] = d_in[i];
  pp[30] = d_out;
  pp[31] = d_ws;
#if MEGA
  (void)hipMemsetAsync((unsigned char*)d_ws + WS_END, 0, XCD_BAR_WORDS * 4, stream);
  int lo = 0, hi = NPHASE;
  void* args[] = {&p, &lo, &hi};
  hipError_t e = hipLaunchCooperativeKernel((const void*)mega, dim3(grid), dim3(512), args, LDS_BYTES, stream);
  if (e != hipSuccess) fprintf(stderr, "cooperative launch failed: %s (grid %d)\n", hipGetErrorString(e), grid);
#else
  for (int ph = 0; ph < NPHASE; ++ph) {
    hipLaunchKernelGGL(mega, dim3(grid), dim3(512), LDS_BYTES, stream, p, ph, ph + 1);
  }
#endif
}
```
